# Optimizing an MI355X kernel written in HIP

```python
import math
import jax, jax.numpy as jnp
from jax import lax
import numpy as np

D_MODEL = 4096
BATCH = 2
SEQ = 8192
DEPTH = 2

GRID_W = 64
CTX_LEN = 256
D_MIX = D_MODEL
W_CONV = D_MIX // 4
W_ATT = D_MIX // 2
W_SSM = D_MIX - W_CONV - W_ATT
ATT_HEAD_DIM = 64
ATT_HEADS = W_ATT // (2 * ATT_HEAD_DIM)
SSM_GROUP = 16
SSM_GROUPS = W_SSM // SSM_GROUP
SSM_STATE = 64
D_FF = 2 * D_MODEL
Q_BLOCK = 128
ROPE_BASE = 10000.0
NORM_EPS = 1e-6
N_MOD = 9

OFF_CONV_H = 0
OFF_CONV_B = W_CONV
OFF_CONV_C = 2 * W_CONV
OFF_Q = 3 * W_CONV
OFF_K = OFF_Q + W_ATT
OFF_V = OFF_K + W_ATT
OFF_U = OFF_V + W_ATT
D_IN_PROJ = OFF_U + W_SSM

kernel_name = "hybrid_conv_diffattn_s5_macaron_dit"


def rmsnorm(x, gain=None):
    x32 = x.astype(jnp.float32)
    y = x32 * lax.rsqrt(jnp.mean(x32 * x32, axis=-1, keepdims=True) + NORM_EPS)
    if gain is not None:
        y = y * gain.astype(jnp.float32)
    return y.astype(x.dtype)


def modulate(x, shift, scale):
    return rmsnorm(x) * (1.0 + scale) + shift


def swiglu(x, w1, w3, w2):
    return (jax.nn.silu(x @ w1) * (x @ w3)) @ w2


def short_conv(h, b_gate, c_gate, conv_w):
    z = c_gate * h
    zp = jnp.pad(z, ((0, 0), (1, 1), (0, 0)))
    zc = zp[:, :-2] * conv_w[0] + zp[:, 1:-1] * conv_w[1] + zp[:, 2:] * conv_w[2]
    return b_gate * zc


def axial_rope_tables(rows):
    row = jnp.repeat(jnp.arange(rows, dtype=jnp.int32), GRID_W).astype(jnp.float32)
    col = jnp.tile(jnp.arange(GRID_W, dtype=jnp.int32), rows).astype(jnp.float32)
    half = ATT_HEAD_DIM // 2
    inv = ROPE_BASE ** (-jnp.arange(0, half, 2, dtype=jnp.float32) / half)
    ang_r = row[:, None] * inv[None]
    ang_c = col[:, None] * inv[None]
    ang = jnp.concatenate([ang_r, ang_r, ang_c, ang_c], axis=-1)
    return jnp.cos(ang), jnp.sin(ang)


def rotate_axial_half(t):
    a1, a2, b1, b2 = jnp.split(t, 4, axis=-1)
    return jnp.concatenate([-a2, a1, -b2, b1], axis=-1)


def apply_axial_rope(t, cos, sin):
    cos = cos[None, :, None, None, :].astype(t.dtype)
    sin = sin[None, :, None, None, :].astype(t.dtype)
    return t * cos + rotate_axial_half(t) * sin


def diff_attend(q, k, v, lam):
    s = jnp.einsum('bqhjd,bkhjd->jbhqk', q, k).astype(jnp.float32) * (ATT_HEAD_DIM ** -0.5)
    p = jax.nn.softmax(s, axis=-1)
    w = p[0] - lam * p[1]
    return jnp.einsum('bhqk,bkhe->bqhe', w.astype(v.dtype), v)


def diff_head_out(o, subln_g, lam_init):
    o = rmsnorm(o, subln_g) * (1.0 - lam_init)
    return o.reshape(o.shape[0], o.shape[1], W_ATT)


def _cmul(ar, ai, br, bi):
    return ar * br - ai * bi, ar * bi + ai * br


def _scan_combine(e1, e2):
    a1r, a1i, b1r, b1i = e1
    a2r, a2i, b2r, b2i = e2
    ar, ai = _cmul(a2r, a2i, a1r, a1i)
    br, bi = _cmul(a2r, a2i, b1r, b1i)
    return ar, ai, br + b2r, bi + b2i


def ssm_discretise(a_re, a_im, log_dt, b_re, b_im):
    dt = jnp.exp(log_dt)[:, None]
    mag = jnp.exp(dt * a_re)
    abar_r = mag * jnp.cos(dt * a_im)
    abar_i = mag * jnp.sin(dt * a_im)
    den = a_re * a_re + a_im * a_im
    nr = abar_r - 1.0
    coef_r = (nr * a_re + abar_i * a_im) / den
    coef_i = (abar_i * a_re - nr * a_im) / den
    bbar_r, bbar_i = _cmul(coef_r[..., None], coef_i[..., None], b_re, b_im)
    return abar_r, abar_i, bbar_r, bbar_i


def ssm_direction(u, disc, reverse, h0=None):
    abar_r, abar_i, bbar_r, bbar_i = disc
    bu_r = jnp.einsum('blgp,gnp->blgn', u, bbar_r)
    bu_i = jnp.einsum('blgp,gnp->blgn', u, bbar_i)
    a_r = jnp.broadcast_to(abar_r, bu_r.shape)
    a_i = jnp.broadcast_to(abar_i, bu_r.shape)
    acc_r, acc_i, h_r, h_i = lax.associative_scan(
        _scan_combine, (a_r, a_i, bu_r, bu_i), reverse=reverse, axis=1)
    if h0 is not None:
        cr, ci = _cmul(acc_r, acc_i, h0[0][:, None], h0[1][:, None])
        h_r = h_r + cr
        h_i = h_i + ci
    return h_r, h_i


def ssm_readout(h_r, h_i, c_re, c_im):
    return jnp.einsum('blgn,gpn->blgp', h_r, c_re) - jnp.einsum('blgn,gpn->blgp', h_i, c_im)


def s5_glu(y, w_glu, dtype):
    y = jax.nn.gelu(y.reshape(y.shape[0], y.shape[1], W_SSM).astype(dtype))
    return y * jax.nn.sigmoid(y @ w_glu)


def ssm_mixer(u_lat, u_ctx, a_re, a_im, log_dt, b_re, b_im, c_re, c_im, d_skip, w_glu, need_ctx):
    dtype = u_lat.dtype
    f32 = jnp.float32
    bsz = u_lat.shape[0]
    ul = u_lat.astype(f32).reshape(bsz, u_lat.shape[1], SSM_GROUPS, SSM_GROUP)
    uc = u_ctx.astype(f32).reshape(bsz, u_ctx.shape[1], SSM_GROUPS, SSM_GROUP)
    d = d_skip.astype(f32).reshape(SSM_GROUPS, SSM_GROUP)
    y_lat = d * ul
    y_ctx = d * uc
    for dirn, rev in ((0, False), (1, True)):
        disc = ssm_discretise(a_re[dirn].astype(f32), a_im[dirn].astype(f32), log_dt[dirn].astype(f32),
                              b_re[dirn].astype(f32), b_im[dirn].astype(f32))
        cr, ci = c_re[dirn].astype(f32), c_im[dirn].astype(f32)
        hc_r, hc_i = ssm_direction(uc, disc, rev)
        last = 0 if rev else -1
        h0 = (hc_r[:, last], hc_i[:, last])
        hl_r, hl_i = ssm_direction(ul, disc, rev, h0)
        y_lat = y_lat + ssm_readout(hl_r, hl_i, cr, ci)
        if need_ctx:
            y_ctx = y_ctx + ssm_readout(hc_r, hc_i, cr, ci)
    out_lat = s5_glu(y_lat, w_glu, dtype)
    out_ctx = s5_glu(y_ctx, w_glu, dtype) if need_ctx else None
    return out_lat, out_ctx


def mixer(h_lat, h_ctx, w_in, w_out, conv_w, lam_q1, lam_k1, lam_q2, lam_k2, subln_g,
          a_re, a_im, log_dt, b_re, b_im, c_re, c_im, d_skip, w_glu,
          rope_cos, rope_sin, lam_init, need_ctx):
    bsz, n_lat, _ = h_lat.shape
    n_ctx = h_ctx.shape[1]
    p_lat = h_lat @ w_in
    base = 0 if need_ctx else OFF_K
    p_ctx = h_ctx @ w_in[:, base:]

    def pl(off, width):
        return p_lat[..., off:off + width]

    def pc(off, width):
        return p_ctx[..., off - base:off - base + width]

    y_conv = short_conv(pl(OFF_CONV_H, W_CONV), pl(OFF_CONV_B, W_CONV), pl(OFF_CONV_C, W_CONV), conv_w)

    f32 = jnp.float32
    lam = (jnp.exp(jnp.sum(lam_q1.astype(f32) * lam_k1.astype(f32)))
           - jnp.exp(jnp.sum(lam_q2.astype(f32) * lam_k2.astype(f32))) + lam_init)

    def heads(t, length):
        return t.reshape(bsz, length, ATT_HEADS, 2, ATT_HEAD_DIM)

    q_lat = apply_axial_rope(heads(pl(OFF_Q, W_ATT), n_lat), rope_cos, rope_sin)
    k_lat = apply_axial_rope(heads(pl(OFF_K, W_ATT), n_lat), rope_cos, rope_sin)
    v_lat = pl(OFF_V, W_ATT).reshape(bsz, n_lat, ATT_HEADS, 2 * ATT_HEAD_DIM)
    k_ctx = heads(pc(OFF_K, W_ATT), n_ctx)
    v_ctx = pc(OFF_V, W_ATT).reshape(bsz, n_ctx, ATT_HEADS, 2 * ATT_HEAD_DIM)
    k_all = jnp.concatenate([k_lat, k_ctx], axis=1)
    v_all = jnp.concatenate([v_lat, v_ctx], axis=1)
    n_blk = n_lat // Q_BLOCK
    qb = q_lat.reshape(bsz, n_blk, Q_BLOCK, ATT_HEADS, 2, ATT_HEAD_DIM).transpose(1, 0, 2, 3, 4, 5)
    ob = lax.map(lambda qq: diff_attend(qq, k_all, v_all, lam), qb)
    o_lat = ob.transpose(1, 0, 2, 3, 4).reshape(bsz, n_lat, ATT_HEADS, 2 * ATT_HEAD_DIM)
    y_att = diff_head_out(o_lat, subln_g, lam_init)

    y_ssm, y_ssm_ctx = ssm_mixer(pl(OFF_U, W_SSM), pc(OFF_U, W_SSM), a_re, a_im, log_dt,
                                 b_re, b_im, c_re, c_im, d_skip, w_glu, need_ctx)

    out_lat = jnp.concatenate([y_conv, y_att, y_ssm], axis=-1) @ w_out
    if not need_ctx:
        return out_lat, None

    y_conv_c = short_conv(pc(OFF_CONV_H, W_CONV), pc(OFF_CONV_B, W_CONV), pc(OFF_CONV_C, W_CONV), conv_w)
    q_ctx = heads(pc(OFF_Q, W_ATT), n_ctx)
    y_att_c = diff_head_out(diff_attend(q_ctx, k_ctx, v_ctx, lam), subln_g, lam_init)
    out_ctx = jnp.concatenate([y_conv_c, y_att_c, y_ssm_ctx], axis=-1) @ w_out
    return out_lat, out_ctx


def setup_inputs(seed: int = 0) -> dict:
    key = jax.random.key(seed)
    ks = iter(jax.random.split(key, 40))
    f32 = jnp.float32

    def nrm(shape, scale):
        return scale * jax.random.normal(next(ks), shape, f32)

    D, L = D_MODEL, DEPTH
    G, N, P = SSM_GROUPS, SSM_STATE, SSM_GROUP
    n_idx = jnp.arange(N, dtype=f32)
    return {
        "x": nrm((BATCH, SEQ, D), 1.0),
        "c": nrm((BATCH, D), 1.0),
        "ctx": nrm((BATCH, CTX_LEN, D), 1.0),
        "c_ctx": nrm((D,), 1.0),
        "w_ada": nrm((L, D, N_MOD * D), 0.5 * D ** -0.5),
        "b_ada": nrm((L, N_MOD * D), 0.02),
        "ffa_w1": nrm((L, D, D_FF), D ** -0.5),
        "ffa_w3": nrm((L, D, D_FF), D ** -0.5),
        "ffa_w2": nrm((L, D_FF, D), D_FF ** -0.5),
        "ffb_w1": nrm((L, D, D_FF), D ** -0.5),
        "ffb_w3": nrm((L, D, D_FF), D ** -0.5),
        "ffb_w2": nrm((L, D_FF, D), D_FF ** -0.5),
        "w_in": nrm((L, D, D_IN_PROJ), D ** -0.5),
        "w_out": nrm((L, D_MIX, D), D_MIX ** -0.5),
        "conv_w": nrm((L, 3, W_CONV), 3 ** -0.5),
        "lam_q1": nrm((L, ATT_HEAD_DIM), 0.1),
        "lam_k1": nrm((L, ATT_HEAD_DIM), 0.1),
        "lam_q2": nrm((L, ATT_HEAD_DIM), 0.1),
        "lam_k2": nrm((L, ATT_HEAD_DIM), 0.1),
        "subln_g": 1.0 + nrm((L, 2 * ATT_HEAD_DIM), 0.02),
        "ssm_a_re": -0.5 * jnp.exp(nrm((L, 2, G, N), 0.05)),
        "ssm_a_im": math.pi * n_idx + nrm((L, 2, G, N), 0.01),
        "ssm_log_dt": jax.random.uniform(next(ks), (L, 2, G), f32, math.log(1e-3), math.log(1e-1)),
        "ssm_b_re": nrm((L, 2, G, N, P), (2 * P) ** -0.5),
        "ssm_b_im": nrm((L, 2, G, N, P), (2 * P) ** -0.5),
        "ssm_c_re": nrm((L, 2, G, P, N), (2 * N) ** -0.5),
        "ssm_c_im": nrm((L, 2, G, P, N), (2 * N) ** -0.5),
        "ssm_d": nrm((L, W_SSM), 1.0),
        "ssm_w_glu": nrm((L, W_SSM, W_SSM), W_SSM ** -0.5),
        "final_g": 1.0 + nrm((D,), 0.02),
    }


def reference(x, c, ctx, c_ctx, w_ada, b_ada, ffa_w1, ffa_w3, ffa_w2, ffb_w1, ffb_w3, ffb_w2,
              w_in, w_out, conv_w, lam_q1, lam_k1, lam_q2, lam_k2, subln_g,
              ssm_a_re, ssm_a_im, ssm_log_dt, ssm_b_re, ssm_b_im, ssm_c_re, ssm_c_im,
              ssm_d, ssm_w_glu, final_g):
    ROWS = x.shape[1] // GRID_W
    rope_cos, rope_sin = axial_rope_tables(ROWS)
    xc = ctx
    for l in range(DEPTH):
        need_ctx = l < DEPTH - 1
        lam_init = 0.8 - 0.6 * math.exp(-0.3 * l)
        mod_lat = jax.nn.silu(c) @ w_ada[l] + b_ada[l]
        mod_ctx = jax.nn.silu(c_ctx) @ w_ada[l] + b_ada[l]
        s1, sc1, g1, s2, sc2, g2, s3, sc3, g3 = jnp.split(mod_lat[:, None, :], N_MOD, axis=-1)
        t1, tc1, h1, t2, tc2, h2, t3, tc3, h3 = jnp.split(mod_ctx, N_MOD, axis=-1)

        x = x + 0.5 * g1 * swiglu(modulate(x, s1, sc1), ffa_w1[l], ffa_w3[l], ffa_w2[l])
        xc = xc + 0.5 * h1 * swiglu(modulate(xc, t1, tc1), ffa_w1[l], ffa_w3[l], ffa_w2[l])

        o_lat, o_ctx = mixer(modulate(x, s2, sc2), modulate(xc, t2, tc2), w_in[l], w_out[l], conv_w[l],
                             lam_q1[l], lam_k1[l], lam_q2[l], lam_k2[l], subln_g[l],
                             ssm_a_re[l], ssm_a_im[l], ssm_log_dt[l], ssm_b_re[l], ssm_b_im[l],
                             ssm_c_re[l], ssm_c_im[l], ssm_d[l], ssm_w_glu[l],
                             rope_cos, rope_sin, lam_init, need_ctx)
        x = x + g2 * o_lat

        x = x + 0.5 * g3 * swiglu(modulate(x, s3, sc3), ffb_w1[l], ffb_w3[l], ffb_w2[l])
        if need_ctx:
            xc = xc + h2 * o_ctx
            xc = xc + 0.5 * h3 * swiglu(modulate(xc, t3, tc3), ffb_w1[l], ffb_w3[l], ffb_w2[l])
    return rmsnorm(x, final_g)
```

```cpp
#include <hip/hip_runtime.h>
#include <hip/hip_bf16.h>
#include <cstdio>
#include <cstdint>
#include <cstddef>
#include <cmath>
constexpr int NIN = 30;
constexpr int D = 4096, BATCH = 2, SEQ = 8192, CTXL = 256, DFF = 8192, NLAT = BATCH * SEQ, NCTX = BATCH * CTXL, MROWS = NLAT + NCTX;
constexpr int WCONV = 1024, WATT = 2048, WSSM = 1024, DIN = 10240, LDP = DIN, OFF_U = 9216, MODW = 9 * D;
constexpr float NORM_EPS = 1e-6f;
constexpr int NWAVES = 8;
constexpr size_t MiB = 1u << 20;
constexpr size_t WS_CTL = 0, CTL_ZERO_BYTES = 1 * MiB;
constexpr size_t WS_MOD = 1 * MiB;
constexpr size_t WS_ROPE = 2 * MiB;
constexpr size_t WS_W = 4 * MiB, W_LAYER = 498 * MiB;
constexpr size_t WL_13A = 0, WL_2A = 128 * MiB, WL_13B = 192 * MiB, WL_2B = 320 * MiB, WL_IN = 384 * MiB, WL_OUT = 464 * MiB, WL_GLU = 496 * MiB;
constexpr size_t WS_X = 1000 * MiB;
constexpr size_t WS_H = 1264 * MiB;
constexpr size_t WS_HID = 1396 * MiB;
constexpr size_t WS_P = 1660 * MiB;
constexpr size_t WS_YCAT = 1990 * MiB;
constexpr size_t WS_YF = 2122 * MiB, WS_YR = 2188 * MiB;
constexpr size_t WS_YPRE = 2254 * MiB;
constexpr size_t WS_ABAR = 2287 * MiB;
constexpr size_t WS_BBR = 2288 * MiB, WS_BBI = 2289 * MiB;
constexpr size_t WS_END = 2290 * MiB;
static_assert(WS_W + 2 * W_LAYER <= WS_X && WS_X + (size_t)MROWS * D * 4 <= WS_H && WS_H + (size_t)MROWS * D * 2 <= WS_HID && WS_HID + (size_t)MROWS * DFF * 2 <= WS_P &&
              WS_P + (size_t)MROWS * DIN * 2 <= WS_YCAT && WS_YCAT + (size_t)MROWS * D * 2 <= WS_YF && WS_YF + (size_t)MROWS * WSSM * 4 <= WS_YR && WS_YR + (size_t)MROWS * WSSM * 4 <= WS_YPRE &&
              WS_YPRE + (size_t)MROWS * WSSM * 2 <= WS_END, "d_ws map");
constexpr int CW_QUEUE = 64, CW_BAR = 4096;
constexpr int P0_SIL_OFF = 69632, P0_RED_OFF = 118784, P0_Q_OFF = 131072;
constexpr int LDSCTL_OFF = 139264, MISC_OFF = LDSCTL_OFF + 320;
constexpr int LDS_BYTES = 147456;
namespace pg8 {
#define PG8_LAS __attribute__((address_space(3)))
typedef unsigned short bf16_t;
typedef short bf16x8 __attribute__((ext_vector_type(8)));
typedef float f32x4 __attribute__((ext_vector_type(4)));
typedef unsigned u32x4 __attribute__((ext_vector_type(4)));
constexpr int BM = 256, BK = 64, HALF = 128, HTB = HALF * BK * 2  , STAGE_BYTES = 8 * HTB, NXCD = 8, WGM = 8;

__host__ __device__ __forceinline__ int lds_byte(int r, int c) { const int st = (r >> 4) * 2 + (c >> 5), rr = r & 15, cc = c & 31, ob = rr * 64 + cc * 2; return st * 1024 + (ob ^ (((ob >> 9) & 1) << 5)); }
__host__ __device__ __forceinline__ void stage_rc(int b, int& R, int& C) { const int st = b / 1024, sb = b % 1024, swz = sb ^ (((sb >> 9) & 1) << 5); R = (st >> 1) * 16 + swz / 64; C = (st & 1) * 32 + (swz % 64) / 2; }
__host__ __device__ __forceinline__ int perm32(int rho) { const int n = rho >> 4, i = rho & 15; return 8 * (i >> 2) + 4 * n + (i & 3); }

struct Unit { int pm, pn; };
struct Gemm { const bf16_t* A; const bf16_t* Bt; int M, N, K; };

struct StaticOrder {
    int nM, nN, nwg, G, c;
    __host__ __device__ void init(int M, int N, int G_, int c_) { nM = M / BM; nN = N / BM; nwg = nM * nN; G = G_; c = c_; }
    __host__ __device__ bool next(int i, Unit& u) const {
        const long L = (long)i * G + c; if (L >= nwg) return false;
        int wgid = (int)L; { const int q = nwg / NXCD, r = nwg % NXCD, xcd = wgid % NXCD, off = wgid / NXCD; wgid = (xcd < r ? xcd * (q + 1) : r * (q + 1) + (xcd - r) * q) + off; }
        const int nig = WGM * nN, gid = wgid / nig, fm = gid * WGM, gsz = (nM - fm) < WGM ? (nM - fm) : WGM;
        u.pm = fm + ((wgid % nig) % gsz); u.pn = (wgid % nig) / gsz; return true;
    }
    __device__ __forceinline__ void a_ready(const Unit&) const {}
    __device__ __forceinline__ void done(const Unit&) const {}
};

__device__ __forceinline__ unsigned cvt_pk_bf16(float lo, float hi) { unsigned r; asm volatile("v_cvt_pk_bf16_f32 %0, %1, %2" : "=v"(r) : "v"(lo), "v"(hi)); return r; }
typedef float f32x2 __attribute__((ext_vector_type(2)));
constexpr int NLAT_ROWS = 16384, DMODEL = 4096, MODW = 36864;
__device__ __forceinline__ int row_set(int pm) { return pm < 32 ? 0 : (pm < 64 ? 1 : 2); }
__device__ __forceinline__ float bf_lo(unsigned w) { return __uint_as_float(w << 16); }
__device__ __forceinline__ float bf_hi(unsigned w) { return __uint_as_float(w & 0xffff0000u); }
__device__ __forceinline__ float sigmoid_f(float a) { return __builtin_amdgcn_rcpf(1.0f + __builtin_amdgcn_exp2f(-1.4426950408889634f * a)); }

struct EpiSwiGLU {
    static constexpr bool PERM = true, AFTER_DRAIN = false;
    bf16_t* O; int ldc;
    __device__ __forceinline__ void operator()(const f32x4 (&acc)[2][2][4][2], const Unit& u, int wr, int wc, int fr, int fq) const {
        const int row0 = u.pm * BM + wr * 64 + fr, col0 = u.pn * HALF + wc * 32 + 8 * fq;
#pragma unroll
        for (int ai = 0; ai < 2; ++ai)
#pragma unroll
            for (int m = 0; m < 4; ++m) { bf16_t* rowp = O + (size_t)(row0 + ai * HALF + m * 16) * ldc + col0;
                float h[8];
#pragma unroll
                for (int n = 0; n < 2; ++n)
#pragma unroll
                    for (int x = 0; x < 4; ++x) { const float a = acc[ai][0][m][n][x], b = acc[ai][1][m][n][x]; h[n * 4 + x] = a * b * sigmoid_f(a); }
                u32x4 w; w.x = cvt_pk_bf16(h[0], h[1]); w.y = cvt_pk_bf16(h[2], h[3]); w.z = cvt_pk_bf16(h[4], h[5]); w.w = cvt_pk_bf16(h[6], h[7]);
                *(u32x4*)rowp = w; }
    }
};
struct EpiResid {
    static constexpr bool PERM = false, AFTER_DRAIN = false;
    const float* base_lat; const float* base_ctx; float* X; const float* gate; float scale;
    __device__ __forceinline__ void operator()(const f32x4 (&acc)[2][2][4][2], const Unit& u, int wr, int wc, int fr, int fq) const {
        const float* g = gate + row_set(u.pm) * MODW; const int col0 = u.pn * BM + wc * 32 + 4 * fq;
        const float* sbase = (u.pm < 64) ? base_lat + (size_t)u.pm * BM * DMODEL : base_ctx + (size_t)(u.pm - 64) * BM * DMODEL;
        f32x4 gv[2][2];
#pragma unroll
        for (int bj = 0; bj < 2; ++bj)
#pragma unroll
            for (int n = 0; n < 2; ++n) gv[bj][n] = *(const f32x4*)(g + col0 + bj * HALF + n * 16) * scale;
#pragma unroll
        for (int ai = 0; ai < 2; ++ai)
#pragma unroll
            for (int m = 0; m < 4; ++m) { const int rl = ai * HALF + wr * 64 + m * 16 + fr;
                const float* src = sbase + (size_t)rl * DMODEL + col0; float* dst = X + (size_t)(u.pm * BM + rl) * DMODEL + col0;
#pragma unroll
                for (int bj = 0; bj < 2; ++bj)
#pragma unroll
                    for (int n = 0; n < 2; ++n) *(f32x4*)(dst + bj * HALF + n * 16) = *(const f32x4*)(src + bj * HALF + n * 16) + gv[bj][n] * acc[ai][bj][m][n]; }
    }
};
struct EpiRope {
    static constexpr bool PERM = false, AFTER_DRAIN = false;
    bf16_t* O; int ldc; const float* tab;
    __device__ __forceinline__ void operator()(const f32x4 (&acc)[2][2][4][2], const Unit& u, int wr, int wc, int fr, int fq) const {
        const bool rope = (u.pn >= 12 && u.pn < 28 && u.pm < 64);
        const int col0 = u.pn * BM + wc * 32 + 4 * fq;
        typedef unsigned u32x2 __attribute__((ext_vector_type(2)));
#pragma unroll
        for (int ai = 0; ai < 2; ++ai)
#pragma unroll
            for (int m = 0; m < 4; ++m) { const int row = u.pm * BM + ai * HALF + wr * 64 + m * 16 + fr; bf16_t* rowp = O + (size_t)row * ldc + col0;
                f32x4 cs = (f32x4){1.f, 1.f, 1.f, 1.f}, sn = (f32x4){0.f, 0.f, 0.f, 0.f};
                if (rope) { const int t = row & 8191, pos = (wc & 1) ? (t & 63) : (t >> 6); cs = *(const f32x4*)(tab + pos * 32 + 4 * fq); sn = *(const f32x4*)(tab + pos * 32 + 16 + 4 * fq); }
#pragma unroll
                for (int bj = 0; bj < 2; ++bj) { const f32x4 v0 = acc[ai][bj][m][0], v1 = acc[ai][bj][m][1];
                    const f32x4 o0 = v0 * cs - v1 * sn, o1 = v1 * cs + v0 * sn;
                    u32x2 w0, w1; w0.x = cvt_pk_bf16(o0[0], o0[1]); w0.y = cvt_pk_bf16(o0[2], o0[3]); w1.x = cvt_pk_bf16(o1[0], o1[1]); w1.y = cvt_pk_bf16(o1[2], o1[3]);
                    *(u32x2*)(rowp + bj * HALF) = w0; *(u32x2*)(rowp + bj * HALF + 16) = w1; } }
    }
};
struct EpiGlu {
    static constexpr bool PERM = true, AFTER_DRAIN = false;
    const bf16_t* Y; int ldy; bf16_t* O; int ldc; int ocol0;
    __device__ __forceinline__ void operator()(const f32x4 (&acc)[2][2][4][2], const Unit& u, int wr, int wc, int fr, int fq) const {
        const int row0 = u.pm * BM + wr * 64 + fr, col0 = u.pn * BM + wc * 32 + 8 * fq;
#pragma unroll
        for (int ai = 0; ai < 2; ++ai)
#pragma unroll
            for (int m = 0; m < 4; ++m) { const size_t row = (size_t)(row0 + ai * HALF + m * 16);
#pragma unroll
                for (int bj = 0; bj < 2; ++bj) { const int c = col0 + bj * HALF; const u32x4 yv = *(const u32x4*)(Y + row * ldy + c);
                    const f32x4 v0 = acc[ai][bj][m][0], v1 = acc[ai][bj][m][1];
                    u32x4 w; w.x = cvt_pk_bf16(bf_lo(yv.x) * sigmoid_f(v0[0]), bf_hi(yv.x) * sigmoid_f(v0[1])); w.y = cvt_pk_bf16(bf_lo(yv.y) * sigmoid_f(v0[2]), bf_hi(yv.y) * sigmoid_f(v0[3]));
                    w.z = cvt_pk_bf16(bf_lo(yv.z) * sigmoid_f(v1[0]), bf_hi(yv.z) * sigmoid_f(v1[1])); w.w = cvt_pk_bf16(bf_lo(yv.w) * sigmoid_f(v1[2]), bf_hi(yv.w) * sigmoid_f(v1[3]));
                    *(u32x4*)(O + row * ldc + ocol0 + c) = w; } }
    }
};
template <class Epi, class Sched, bool ALIGN_EPI = false, bool SP2 = false>
__device__ __forceinline__ void gemm_phase(PG8_LAS unsigned char* lds, const Gemm g, const Sched& S, const Epi& E) {
    int tid_ = threadIdx.x; asm volatile("" : "+v"(tid_));
    const int tid = tid_, wid = __builtin_amdgcn_readfirstlane(tid >> 6), lane = tid & 63, wr = wid >> 2, wc = wid & 3, fr = lane & 15, fq = lane >> 4;
    const int K = g.K, nt = K / BK;
    unsigned voffA[2], voffB[2];
#pragma unroll
    for (int i = 0; i < 2; ++i) { int R, C; stage_rc(tid * 16 + i * 8192, R, C); const int Rb = Epi::PERM ? ((R & ~31) + perm32(R & 31)) : R;
        voffA[i] = (unsigned)(R * K + C) * 2u; voffB[i] = (unsigned)(Rb * K + C) * 2u; }
    const size_t kstep = (size_t)(BK * 2);
    const size_t hstep = (size_t)HALF * K * 2;
    const size_t tstep = 2 * hstep;
    const unsigned ldsw = (unsigned)wid * 1024u;
    const int aoff = lds_byte(wr * 64 + fr, fq * 8), boff = lds_byte(wc * 32 + fr, fq * 8);
#define PG8_SA(b, h) (((b) * 2 + (h)) * HTB)
#define PG8_SB(b, h) ((4 + (b) * 2 + (h)) * HTB)
#define PG8_STAGE(bufoff, gbase, voff) do { _Pragma("unroll") for (int _i = 0; _i < 2; ++_i) \
        __builtin_amdgcn_global_load_lds((const unsigned*)((const char*)(gbase) + (voff)[_i]), (PG8_LAS unsigned*)(lds + (bufoff) + ldsw + _i * 8192), 16, 0, 0); } while (0)
#define PG8_LDA(dst, b, h) do { _Pragma("unroll") for (int m = 0; m < 4; ++m) _Pragma("unroll") for (int k = 0; k < 2; ++k) dst[m][k] = *(const PG8_LAS bf16x8*)(lds + PG8_SA(b, h) + aoff + m * 2048 + k * 1024); } while (0)
#define PG8_LDB(dst, b, h) do { _Pragma("unroll") for (int n = 0; n < 2; ++n) _Pragma("unroll") for (int k = 0; k < 2; ++k) dst[n][k] = *(const PG8_LAS bf16x8*)(lds + PG8_SB(b, h) + boff + n * 2048 + k * 1024); } while (0)
#define PG8_MMA(ai, bj, At, Bt) do { __builtin_amdgcn_s_setprio(1); _Pragma("unroll") for (int m = 0; m < 4; ++m) _Pragma("unroll") for (int n = 0; n < 2; ++n) _Pragma("unroll") for (int k = 0; k < 2; ++k) \
        acc[ai][bj][m][n] = __builtin_amdgcn_mfma_f32_16x16x32_bf16(Bt[n][k], At[m][k], acc[ai][bj][m][n], 0, 0, 0); __builtin_amdgcn_s_setprio(0); } while (0)
#define PG8_WAIT_V(n) asm volatile("s_waitcnt vmcnt(" #n ")" ::: "memory")
#define PG8_WAIT_L(n) asm volatile("s_waitcnt lgkmcnt(" #n ")" ::: "memory")
#define PG8_BAR __builtin_amdgcn_s_barrier()
#define PG8_SCHED __builtin_amdgcn_sched_barrier(0)
    Unit cur, nxt; int ui = 0;
    if (!S.next(0, cur)) return;
    f32x4 acc[2][2][4][2];
#pragma unroll
    for (int a = 0; a < 2; ++a)
#pragma unroll
        for (int b = 0; b < 2; ++b)
#pragma unroll
            for (int m = 0; m < 4; ++m)
#pragma unroll
                for (int n = 0; n < 2; ++n) acc[a][b][m][n] = (f32x4){0.f, 0.f, 0.f, 0.f};
    bf16x8 At[4][2], B0[2][2], B1[2][2];
    const char* cA = (const char*)g.A + (size_t)cur.pm * tstep; const char* cB = (const char*)g.Bt + (size_t)cur.pn * tstep;
    S.a_ready(cur);
    if constexpr (SP2) {
        PG8_STAGE(PG8_SB(0, 0), cB, voffB); PG8_STAGE(PG8_SB(0, 1), cB + hstep, voffB); PG8_STAGE(PG8_SA(0, 0), cA, voffA); PG8_STAGE(PG8_SA(0, 1), cA + hstep, voffA);
        if (wr == 1) PG8_BAR;
        PG8_WAIT_V(2); PG8_BAR;
        PG8_STAGE(PG8_SB(1, 0), cB + kstep, voffB); PG8_STAGE(PG8_SA(1, 0), cA + kstep, voffA); PG8_STAGE(PG8_SB(1, 1), cB + hstep + kstep, voffB);
        PG8_WAIT_V(6); PG8_BAR;
    } else {
        PG8_STAGE(PG8_SB(0, 0), cB, voffB); PG8_STAGE(PG8_SA(0, 0), cA, voffA); PG8_STAGE(PG8_SB(0, 1), cB + hstep, voffB); PG8_STAGE(PG8_SA(0, 1), cA + hstep, voffA);
        if (wr == 1) PG8_BAR;
        PG8_WAIT_V(4); PG8_BAR;
        PG8_STAGE(PG8_SB(1, 0), cB + kstep, voffB); PG8_STAGE(PG8_SA(1, 0), cA + kstep, voffA); PG8_STAGE(PG8_SB(1, 1), cB + hstep + kstep, voffB);
        PG8_WAIT_V(6); PG8_BAR;
    }
    for (;;) {
        const bool has_next = S.next(ui + 1, nxt);
        const char* nA = has_next ? (const char*)g.A + (size_t)nxt.pm * tstep : cA; const char* nB = has_next ? (const char*)g.Bt + (size_t)nxt.pn * tstep : cB;
        for (int t = 0; t < nt; t += 2) {
            const bool last = (t == nt - 2);
            const char* a1 = cA + (size_t)(t + 1) * kstep;
            const char* a2 = last ? nA : cA + (size_t)(t + 2) * kstep; const char* b2 = last ? nB : cB + (size_t)(t + 2) * kstep;
            const char* a3 = a2 + kstep; const char* b3 = b2 + kstep;
            if (last && has_next) S.a_ready(nxt);
            if constexpr (SP2) {
            PG8_LDB(B0, 0, 0); PG8_LDB(B1, 0, 1); PG8_SCHED; PG8_LDA(At, 0, 0); PG8_STAGE(PG8_SA(1, 1), a1 + hstep, voffA);
            PG8_WAIT_V(8); PG8_WAIT_L(0); PG8_BAR; PG8_MMA(0, 0, At, B0); PG8_MMA(0, 1, At, B1); PG8_BAR; PG8_SCHED;
            PG8_LDA(At, 0, 1); PG8_STAGE(PG8_SB(0, 0), b2, voffB); PG8_STAGE(PG8_SB(0, 1), b2 + hstep, voffB); PG8_STAGE(PG8_SA(0, 0), a2, voffA);
            PG8_WAIT_V(8); PG8_WAIT_L(0); PG8_BAR; PG8_MMA(1, 0, At, B0); PG8_MMA(1, 1, At, B1); PG8_BAR; PG8_SCHED;
            PG8_LDB(B0, 1, 0); PG8_LDB(B1, 1, 1); PG8_SCHED; PG8_LDA(At, 1, 0); PG8_STAGE(PG8_SA(0, 1), a2 + hstep, voffA);
            PG8_WAIT_V(8); PG8_WAIT_L(0); PG8_BAR; PG8_MMA(0, 0, At, B0); PG8_MMA(0, 1, At, B1); PG8_BAR; PG8_SCHED;
            PG8_LDA(At, 1, 1); PG8_STAGE(PG8_SB(1, 0), b3, voffB); PG8_STAGE(PG8_SB(1, 1), b3 + hstep, voffB); PG8_STAGE(PG8_SA(1, 0), a3, voffA);
            PG8_WAIT_V(8); PG8_WAIT_L(0); PG8_BAR; PG8_MMA(1, 0, At, B0); PG8_MMA(1, 1, At, B1); PG8_BAR; PG8_SCHED;
            } else {
            PG8_LDB(B0, 0, 0); PG8_SCHED; PG8_LDA(At, 0, 0); PG8_STAGE(PG8_SA(1, 1), a1 + hstep, voffA);
            PG8_WAIT_L(8); PG8_BAR; PG8_WAIT_L(0); PG8_MMA(0, 0, At, B0); PG8_BAR; PG8_SCHED;
            PG8_LDB(B1, 0, 1); PG8_STAGE(PG8_SB(0, 0), b2, voffB);
            PG8_BAR; PG8_WAIT_L(0); PG8_MMA(0, 1, At, B1); PG8_BAR;
            PG8_LDA(At, 0, 1); PG8_STAGE(PG8_SA(0, 0), a2, voffA);
            PG8_BAR; PG8_WAIT_L(0); PG8_MMA(1, 0, At, B0); PG8_BAR; PG8_SCHED;
            PG8_STAGE(PG8_SB(0, 1), b2 + hstep, voffB);
            PG8_WAIT_V(6); PG8_BAR; PG8_MMA(1, 1, At, B1); PG8_BAR;
            PG8_LDB(B0, 1, 0); PG8_SCHED; PG8_LDA(At, 1, 0); PG8_STAGE(PG8_SA(0, 1), a2 + hstep, voffA);
            PG8_WAIT_L(8); PG8_BAR; PG8_WAIT_L(0); PG8_MMA(0, 0, At, B0); PG8_BAR; PG8_SCHED;
            PG8_LDB(B1, 1, 1); PG8_STAGE(PG8_SB(1, 0), b3, voffB);
            PG8_BAR; PG8_WAIT_L(0); PG8_MMA(0, 1, At, B1); PG8_BAR;
            PG8_LDA(At, 1, 1); PG8_STAGE(PG8_SA(1, 0), a3, voffA);
            PG8_BAR; PG8_WAIT_L(0); PG8_MMA(1, 0, At, B0); PG8_BAR; PG8_SCHED;
            PG8_STAGE(PG8_SB(1, 1), b3 + hstep, voffB);
            PG8_WAIT_V(6); PG8_BAR; PG8_MMA(1, 1, At, B1); PG8_BAR;
            }
        }
        if constexpr (ALIGN_EPI) { if (wr == 0) PG8_BAR; }
        if constexpr (!Epi::AFTER_DRAIN) { E(acc, cur, wr, wc, fr, fq); S.done(cur); }
        if (!has_next) break;
#pragma unroll
        for (int a = 0; a < 2; ++a)
#pragma unroll
            for (int b = 0; b < 2; ++b)
#pragma unroll
                for (int m = 0; m < 4; ++m)
#pragma unroll
                    for (int n = 0; n < 2; ++n) acc[a][b][m][n] = (f32x4){0.f, 0.f, 0.f, 0.f};
        cur = nxt; cA = nA; cB = nB; ++ui;
        if constexpr (ALIGN_EPI) { if (wr == 1) PG8_BAR; }
    }
    PG8_WAIT_V(0);
    if constexpr (!ALIGN_EPI) { if (wr == 0) PG8_BAR; }
    PG8_BAR;
    if constexpr (Epi::AFTER_DRAIN) { E.fused(acc, cur, wr, wc, fr, fq, lds, wid, lane); S.done(cur); }
#undef PG8_SA
#undef PG8_SB
#undef PG8_STAGE
#undef PG8_LDA
#undef PG8_LDB
#undef PG8_MMA
#undef PG8_WAIT_V
#undef PG8_WAIT_L
#undef PG8_BAR
#undef PG8_SCHED
}
}
namespace att {
using bf16x8 = __attribute__((ext_vector_type(8))) short;
using s16x4  = __attribute__((ext_vector_type(4))) short;
using f32x16 = __attribute__((ext_vector_type(16))) float;
using u32x4  = __attribute__((ext_vector_type(4))) unsigned;
typedef unsigned short bf16_t;
constexpr int NW = 8, QBLK = 32, KVBLK = 64, LDP = 10240, LDY = 4096;
constexpr int OFF_Q = 3072, OFF_K = 5120, OFF_V = 7168, YC_ATT = 1024;
constexpr float SCALE = 0.125f, THR = 8.f;
constexpr int SHM_V = KVBLK * 128 * 2, SHM_K = KVBLK * 128 * 2, SHM_ATTN = 2 * SHM_V + 2 * SHM_K + NW * 64 * 4;
#define KSWZ(row, colB) ((row) * 256 + ((colB) ^ (((row) & 7) << 4)))
#define SBAR() __builtin_amdgcn_sched_barrier(0)
__device__ __forceinline__ int crow(int r, int hi) { return (r & 3) + 8 * (r >> 2) + 4 * hi; }
__device__ __forceinline__ unsigned cvtpk(float lo, float hi) { unsigned r; asm volatile("v_cvt_pk_bf16_f32 %0, %1, %2" : "=v"(r) : "v"(lo), "v"(hi)); return r; }
__device__ __forceinline__ bf16x8 ld8(const bf16_t* p) { return *reinterpret_cast<const bf16x8*>(p); }

__device__ __forceinline__ void partialSM(f32x16& p0, f32x16& p1, float& m_reg, float& mn, float& alpha) {
  constexpr float C = SCALE * 1.4426950408889634f;
  float pmax = p0[0];
#pragma unroll
  for (int r = 1; r < 16; ++r) pmax = fmaxf(pmax, p0[r]);
#pragma unroll
  for (int r = 0; r < 16; ++r) pmax = fmaxf(pmax, p1[r]);
  { auto rr = __builtin_amdgcn_permlane32_swap(__float_as_uint(pmax), __float_as_uint(pmax), false, false);
    pmax = fmaxf(__uint_as_float(rr[0]), __uint_as_float(rr[1])); }
  if (__builtin_expect(__all(pmax - m_reg <= THR / SCALE), 1)) { mn = m_reg; alpha = 1.f; }
  else { mn = fmaxf(m_reg, pmax); alpha = __builtin_amdgcn_exp2f((m_reg - mn) * C); m_reg = mn; }
  float mnC = -mn * C;
#pragma unroll
  for (int r = 0; r < 16; ++r) p0[r] = fmaf(p0[r], C, mnC);
#pragma unroll
  for (int r = 0; r < 16; ++r) p1[r] = fmaf(p1[r], C, mnC);
#pragma unroll
  for (int r = 0; r < 16; ++r) p0[r] = __builtin_amdgcn_exp2f(p0[r]);
}
__device__ __forceinline__ void finishSM(f32x16& p0, f32x16& p1, float alpha, float& l_reg, bf16x8& pa0, bf16x8& pa1, bf16x8& pa2, bf16x8& pa3) {
#pragma unroll
  for (int r = 0; r < 16; ++r) p1[r] = __builtin_amdgcn_exp2f(p1[r]);
  float ps = 0;
#pragma unroll
  for (int r = 0; r < 16; ++r) ps += p0[r];
#pragma unroll
  for (int r = 0; r < 16; ++r) ps += p1[r];
  { auto rr = __builtin_amdgcn_permlane32_swap(__float_as_uint(ps), __float_as_uint(ps), false, false);
    ps = __uint_as_float(rr[0]) + __uint_as_float(rr[1]); }
  l_reg = l_reg * alpha + ps;
#define PK4(P, BASE, OUT) do { unsigned a0 = cvtpk(P[BASE + 0], P[BASE + 1]), a1 = cvtpk(P[BASE + 2], P[BASE + 3]);   \
    unsigned b0 = cvtpk(P[BASE + 4], P[BASE + 5]), b1 = cvtpk(P[BASE + 6], P[BASE + 7]);                              \
    auto r0 = __builtin_amdgcn_permlane32_swap(a0, b0, false, false); auto r1 = __builtin_amdgcn_permlane32_swap(a1, b1, false, false); \
    u32x4 w = {r0[0], r1[0], r0[1], r1[1]}; OUT = *reinterpret_cast<bf16x8*>(&w); } while (0)
  PK4(p0, 0, pa0); PK4(p0, 8, pa1); PK4(p1, 0, pa2); PK4(p1, 8, pa3);
#undef PK4
}
__device__ __forceinline__ void qkt(f32x16& p0, f32x16& p1, const char* Ks, const bf16x8* qr, int r32, int hi, int colB0) {
  p0 = f32x16{}; p1 = f32x16{};
#pragma unroll
  for (int d0 = 0; d0 < 4; ++d0) { int cb = colB0 + (d0 * 16 + hi * 8) * 2;
    bf16x8 b0 = *reinterpret_cast<const bf16x8*>(Ks + KSWZ(r32, cb));
    bf16x8 b1 = *reinterpret_cast<const bf16x8*>(Ks + KSWZ(32 + r32, cb));
    p0 = __builtin_amdgcn_mfma_f32_32x32x16_bf16(b0, qr[d0], p0, 0, 0, 0);
    p1 = __builtin_amdgcn_mfma_f32_32x32x16_bf16(b1, qr[d0], p1, 0, 0, 0); }
}
__device__ __forceinline__ int v_st(int k, int c) { const int kk = (k & ~0xC) | ((k & 4) << 1) | ((k & 8) >> 1); return ((kk >> 3) * 4 + (c >> 5)) * 512 + ((kk & 7) * 32 + (c & 31)) * 2; }
__device__ __forceinline__ int v_rd_base(int lane) { return ((lane & 3) << 3) | (((lane >> 2) & 3) << 6) | (((lane >> 4) & 1) << 5) | (((lane >> 5) & 1) << 8); }
constexpr int v_rd_off(int d0, int ks, int half) { return d0 * 512 + ks * 4096 + half * 2048; }
template <int OFF> __device__ __forceinline__ s16x4 tr_read(int vb) {
  s16x4 r; asm volatile("ds_read_b64_tr_b16 %0, %1 offset:%2" : "=&v"(r) : "v"(vb), "i"(OFF) : "memory"); return r;
}
template <int D0> __device__ __forceinline__ void pv_one(f32x16& od, int vb, bf16x8 pa0, bf16x8 pa1, bf16x8 pa2, bf16x8 pa3) {
  const s16x4 l0 = tr_read<v_rd_off(D0, 0, 0)>(vb), h0 = tr_read<v_rd_off(D0, 0, 1)>(vb), l1 = tr_read<v_rd_off(D0, 1, 0)>(vb), h1 = tr_read<v_rd_off(D0, 1, 1)>(vb);
  const s16x4 l2 = tr_read<v_rd_off(D0, 2, 0)>(vb), h2 = tr_read<v_rd_off(D0, 2, 1)>(vb), l3 = tr_read<v_rd_off(D0, 3, 0)>(vb), h3 = tr_read<v_rd_off(D0, 3, 1)>(vb);
  asm volatile("s_waitcnt lgkmcnt(0)" ::: "memory"); SBAR();
#define PK(L, H) (bf16x8){L[0], L[1], L[2], L[3], H[0], H[1], H[2], H[3]}
  od = __builtin_amdgcn_mfma_f32_32x32x16_bf16(pa0, PK(l0, h0), od, 0, 0, 0);
  od = __builtin_amdgcn_mfma_f32_32x32x16_bf16(pa1, PK(l1, h1), od, 0, 0, 0);
  od = __builtin_amdgcn_mfma_f32_32x32x16_bf16(pa2, PK(l2, h2), od, 0, 0, 0);
  od = __builtin_amdgcn_mfma_f32_32x32x16_bf16(pa3, PK(l3, h3), od, 0, 0, 0);
#undef PK
}
__device__ __forceinline__ void pv_d0(f32x16* o, int vb, bf16x8 pa0, bf16x8 pa1, bf16x8 pa2, bf16x8 pa3) {
  pv_one<0>(o[0], vb, pa0, pa1, pa2, pa3); pv_one<1>(o[1], vb, pa0, pa1, pa2, pa3); pv_one<2>(o[2], vb, pa0, pa1, pa2, pa3); pv_one<3>(o[3], vb, pa0, pa1, pa2, pa3);
}

struct AttnArgs { const bf16_t* P; bf16_t* YC; const float* subg; float lam, oscale; };
__device__ __forceinline__ void attn_unit(const AttnArgs& A, int qrow0, int h, int krow_a, int nt_a, int krow_b, int NT, char* lds) {
  int tid_ = threadIdx.x; asm volatile("" : "+v"(tid_));
  const int tid = tid_, wid = __builtin_amdgcn_readfirstlane(tid >> 6), lane = tid & 63, r32 = lane & 31, hi = lane >> 5;
  const int js = wid >> 2, qw = wid & 3;
  char* V_lds = lds; char* K_lds = lds + 2 * SHM_V;
  float* ws = (float*)(lds + 2 * SHM_V + 2 * SHM_K) + wid * 64; float* li_l = ws; float* al_l = ws + 32;
  float m_reg = -1e30f, l_reg = 0; f32x16 o[4] = {}; bf16x8 qr[4];
  const bf16_t* Qw = A.P + (size_t)(qrow0 + qw * QBLK + r32) * LDP + OFF_Q + h * 128 + js * 64 + hi * 8;
#pragma unroll
  for (int d0 = 0; d0 < 4; ++d0) qr[d0] = ld8(Qw + d0 * 16);
  const bf16_t* Kh = A.P + OFF_K + h * 128; const bf16_t* Vh = A.P + OFF_V + h * 128;
  const int sr = tid >> 4, sc = (tid & 15) * 8, vst0 = v_st(sr, sc), vst1 = v_st(32 + sr, sc);
  const int vb0 = (int)(uintptr_t)V_lds + v_rd_base(lane);
  const int colB0 = js * 128;
  struct { bf16x8 vs0, vs1, ks0, ks1; } sr_[2];
#define TROW(t) ((t) < nt_a ? krow_a + (t) * KVBLK : krow_b + ((t) - nt_a) * KVBLK)
#define SLOAD(i, t) do { const size_t rb_ = (size_t)(TROW(t)); sr_[i].vs0 = ld8(&Vh[(rb_ + sr) * LDP + sc]); sr_[i].vs1 = ld8(&Vh[(rb_ + 32 + sr) * LDP + sc]); \
    sr_[i].ks0 = ld8(&Kh[(rb_ + sr) * LDP + sc]); sr_[i].ks1 = ld8(&Kh[(rb_ + 32 + sr) * LDP + sc]); } while (0)
#define SWRITE(b, i) do { *(bf16x8*)(V_lds + (b) * SHM_V + vst0) = sr_[i].vs0; *(bf16x8*)(V_lds + (b) * SHM_V + vst1) = sr_[i].vs1; int kc = sc * 2;  \
    *(bf16x8*)(K_lds + (b) * SHM_K + KSWZ(sr, kc)) = sr_[i].ks0; *(bf16x8*)(K_lds + (b) * SHM_K + KSWZ(32 + sr, kc)) = sr_[i].ks1; } while (0)
#define SWAIT() asm volatile("s_waitcnt vmcnt(4)" ::: "memory")
#define RESC(a) do { if (__any((a) < 1.f)) { if (hi == 0) al_l[r32] = (a); asm volatile("s_waitcnt lgkmcnt(0)" ::: "memory"); \
    _Pragma("unroll") for (int d = 0; d < 4; ++d) _Pragma("unroll") for (int r = 0; r < 16; ++r) o[d][r] *= al_l[crow(r, hi)]; } } while (0)
  f32x16 pA0, pA1, pB0, pB1; float mnA, mnB, alA, alB; bf16x8 pa0, pa1, pa2, pa3;
  constexpr int SE = 0, SO = 1;
  SLOAD(SE, 0); asm volatile("s_waitcnt vmcnt(0)" ::: "memory"); SWRITE(0, SE); __syncthreads();
  qkt(pA0, pA1, K_lds, qr, r32, hi, colB0); partialSM(pA0, pA1, m_reg, mnA, alA);
  SLOAD(SO, 1); if (2 < NT) SLOAD(SE, 2);
  SWAIT(); SWRITE(1, SO); __syncthreads();
  for (int j = 1; j + 1 < NT; j += 2) {
    SBAR(); qkt(pB0, pB1, K_lds + SHM_K, qr, r32, hi, colB0);
    finishSM(pA0, pA1, alA, l_reg, pa0, pa1, pa2, pa3); SBAR();
    SLOAD(SO, j + 2); SBAR();
    pv_d0(o, vb0, pa0, pa1, pa2, pa3); partialSM(pB0, pB1, m_reg, mnB, alB);
    __syncthreads(); SWAIT(); SWRITE(0, SE);
    RESC(alB); __syncthreads();
    SBAR(); qkt(pA0, pA1, K_lds, qr, r32, hi, colB0);
    finishSM(pB0, pB1, alB, l_reg, pa0, pa1, pa2, pa3); SBAR();
    if (j + 3 < NT) SLOAD(SE, j + 3); SBAR();
    pv_d0(o, vb0 + SHM_V, pa0, pa1, pa2, pa3); partialSM(pA0, pA1, m_reg, mnA, alA);
    __syncthreads(); SWAIT(); SWRITE(1, SO);
    RESC(alA); __syncthreads();
  }
  SBAR(); qkt(pB0, pB1, K_lds + SHM_K, qr, r32, hi, colB0);
  finishSM(pA0, pA1, alA, l_reg, pa0, pa1, pa2, pa3); SBAR();
  pv_d0(o, vb0, pa0, pa1, pa2, pa3); partialSM(pB0, pB1, m_reg, mnB, alB);
  __syncthreads(); RESC(alB);
  finishSM(pB0, pB1, alB, l_reg, pa0, pa1, pa2, pa3); SBAR();
  pv_d0(o, vb0 + SHM_V, pa0, pa1, pa2, pa3);
  if (hi == 0) li_l[r32] = l_reg; asm volatile("s_waitcnt lgkmcnt(0)" ::: "memory");
  float rli[16];
#pragma unroll
  for (int r = 0; r < 16; ++r) rli[r] = __builtin_amdgcn_rcpf(li_l[crow(r, hi)]);
  __syncthreads();
  float* X2 = (float*)lds + qw * (32 * 128);
  if (js == 1) {
#pragma unroll
    for (int r = 0; r < 16; ++r) { const float f = rli[r] * A.lam;
#pragma unroll
      for (int d0 = 0; d0 < 4; ++d0) X2[crow(r, hi) * 128 + d0 * 32 + r32] = o[d0][r] * f; }
  }
  __syncthreads();
  if (js == 0) {
    float gq[4];
#pragma unroll
    for (int d0 = 0; d0 < 4; ++d0) gq[d0] = A.subg[d0 * 32 + r32] * A.oscale;
    bf16_t* Yw = A.YC + (size_t)(qrow0 + qw * QBLK) * LDY + YC_ATT + h * 128 + r32;
#pragma unroll
    for (int r = 0; r < 16; ++r) { float v[4]; float ss = 0.f;
#pragma unroll
      for (int d0 = 0; d0 < 4; ++d0) { v[d0] = o[d0][r] * rli[r] - X2[crow(r, hi) * 128 + d0 * 32 + r32]; ss += v[d0] * v[d0]; }
      ss += __shfl_xor(ss, 1); ss += __shfl_xor(ss, 2); ss += __shfl_xor(ss, 4); ss += __shfl_xor(ss, 8); ss += __shfl_xor(ss, 16);
      const float rn = 1.0f / sqrtf(ss * (1.0f / 128.0f) + 1e-6f);
#pragma unroll
      for (int d0 = 0; d0 < 4; ++d0) { const float y = v[d0] * rn * gq[d0]; Yw[(size_t)crow(r, hi) * LDY + d0 * 32] = (bf16_t)(cvtpk(y, y) & 0xffffu); } }
  }
  __syncthreads();
#undef TROW
#undef SLOAD
#undef SWRITE
#undef SWAIT
#undef RESC
}
#undef KSWZ
#undef SBAR
}
#define GAS __attribute__((address_space(1)))
#define LAS __attribute__((address_space(3)))
typedef unsigned short bf16;
typedef unsigned v4u __attribute__((ext_vector_type(4)));
typedef float f32x4 __attribute__((ext_vector_type(4)));
typedef short bf16x8 __attribute__((ext_vector_type(8)));
typedef GAS unsigned gu32;
typedef GAS unsigned long long gu64;
#define RLX_AGENT __ATOMIC_RELAXED, __HIP_MEMORY_SCOPE_AGENT
#define LDS_WAIT() asm volatile("s_waitcnt lgkmcnt(0)" ::: "memory")
#define VM_WAIT() asm volatile("s_waitcnt vmcnt(0)" ::: "memory")
__device__ __forceinline__ unsigned long long rt() { return __builtin_amdgcn_s_memrealtime(); }
__device__ __forceinline__ unsigned f2bf(float f) { unsigned u = __builtin_bit_cast(unsigned, f); return (u + 0x7fffu + ((u >> 16) & 1u)) >> 16; }
__device__ __forceinline__ unsigned pk2(float lo, float hi) { return f2bf(lo) | (f2bf(hi) << 16); }
#define XB_TMO      128
#define XB_XCNT(j)  (256  + 64 * (j))
#define XB_XSUB(j)  (1280 + 64 * (j))
#define XB_XGEN(j)  (2304 + 64 * (j))
#define XB_TOP      3328
#define XB_TOPGEN   3392
#define XCD_BAR_WORDS 3456
#define XB_SPIN_CAP (1u << 18)

__device__ __forceinline__ unsigned xb_ld(unsigned* p)              { return __hip_atomic_load(p, __ATOMIC_RELAXED, __HIP_MEMORY_SCOPE_AGENT); }
__device__ __forceinline__ unsigned xb_add(unsigned* p, unsigned v) { return __hip_atomic_fetch_add(p, v, __ATOMIC_RELAXED, __HIP_MEMORY_SCOPE_AGENT); }
__device__ __forceinline__ unsigned xb_xcc_id() { return (unsigned)__builtin_amdgcn_s_getreg((3 << 11) | 20) & 0xFu; }
#define XB_SPIN(cond, bar) do { unsigned _sp = 0; while (cond) { __builtin_amdgcn_s_sleep(1); \
    if ((++_sp & 255u) == 0u) { if (xb_ld(&(bar)[XB_TMO])) break; if (_sp > XB_SPIN_CAP) { atomicAdd(&(bar)[XB_TMO], 1u); break; } } } } while (0)

struct XcdBarrier {
    unsigned* bar; unsigned x;
    volatile LAS unsigned* st;
};

__device__ __forceinline__ XcdBarrier xcd_barrier_post(unsigned* bar, volatile LAS unsigned* st) {
    XcdBarrier b; b.bar = bar; b.x = xb_xcc_id(); b.st = st;
    if (threadIdx.x == 0) (void)xb_add(&bar[XB_XCNT(b.x)], 1u);
    return b;
}
__device__ __forceinline__ void xcd_barrier_complete(unsigned* bar, unsigned x, unsigned& nloc, unsigned& nx) {
    const unsigned G = gridDim.x * gridDim.y * gridDim.z;
    unsigned sum, cnt, mine, sp = 0u;
    for (;;) {
        sum = 0u; cnt = 0u; mine = 0u;
#pragma unroll
        for (unsigned j = 0; j < 16; ++j) { const unsigned c = xb_ld(&bar[XB_XCNT(j)]); sum += c; cnt += (c > 0u) ? 1u : 0u; mine = (j == x) ? c : mine; }
        if (sum == G) break;
        __builtin_amdgcn_s_sleep(1);
        if ((++sp & 255u) == 0u) { if (xb_ld(&bar[XB_TMO])) break; if (sp > XB_SPIN_CAP) { atomicAdd(&bar[XB_TMO], 1u); break; } }
    }
    nloc = mine > 0u ? mine : 1u; nx = cnt > 0u ? cnt : 1u;
}

__device__ __forceinline__ void xcd_barrier(const XcdBarrier& b) {
    asm volatile("s_waitcnt vmcnt(0)" ::: "memory");
    __syncthreads();
    if (threadIdx.x == 0) {
        unsigned* bar = b.bar;
        __builtin_amdgcn_s_waitcnt(0);
        unsigned nloc = b.st[0], nx = b.st[1];
        if (nloc == 0u) { xcd_barrier_complete(bar, b.x, nloc, nx); b.st[0] = nloc; b.st[1] = nx; }
        const unsigned old = xb_add(&bar[XB_XSUB(b.x)], 1u);
        const unsigned gen = old / nloc;
        if (old + 1u == (gen + 1u) * nloc) {
            __builtin_amdgcn_fence(__ATOMIC_RELEASE, "agent");
            asm volatile("s_waitcnt vmcnt(0)" ::: "memory");
            const unsigned og = xb_add(&bar[XB_TOP], 1u);
            const unsigned tg = og / nx;
            if (og + 1u == (tg + 1u) * nx) xb_add(&bar[XB_TOPGEN], 1u);
            else XB_SPIN(xb_ld(&bar[XB_TOPGEN]) == tg, bar);
            __builtin_amdgcn_fence(__ATOMIC_ACQUIRE, "agent");
            xb_add(&bar[XB_XGEN(b.x)], 1u);
            asm volatile("s_waitcnt vmcnt(0)" ::: "memory");
        } else {
            XB_SPIN(xb_ld(&bar[XB_XGEN(b.x)]) == gen, bar);
            __builtin_amdgcn_fence(__ATOMIC_ACQUIRE, "agent");
            asm volatile("s_waitcnt vmcnt(0)" ::: "memory");
        }
    }
    __syncthreads();
}

typedef decltype(__builtin_amdgcn_kernarg_segment_ptr()) kargp_t;
struct Frame {
    LAS unsigned char* lds;
    volatile LAS unsigned* MISC;
    gu32* ctl;
    int tid, lane, wave;
    int vcu, G;
    kargp_t kp;
    float* out;
    unsigned char* ws;
};
#define FIN(i) (((const float* const*)F.kp)[i])
#define WSP(T, off) ((T*)(F.ws + (off)))

__device__ __forceinline__ float wave_sum(float v) {
#pragma unroll
    for (int o = 1; o < 64; o <<= 1) v += __shfl_xor(v, o);
    return v;
}
__device__ __forceinline__ void dsincos(double x, double& s, double& c) {
    const double kd = rint(x * 0.63661977236758134308);
    double r = fma(-kd, 1.57079632679489655800e+00, x); r = fma(-kd, 6.12323399573676603587e-17, r);
    const double r2 = r * r;
    double sp = -1.0 / 1307674368000.0; sp = sp * r2 + 1.0 / 6227020800.0; sp = sp * r2 - 1.0 / 39916800.0; sp = sp * r2 + 1.0 / 362880.0; sp = sp * r2 - 1.0 / 5040.0; sp = sp * r2 + 1.0 / 120.0; sp = sp * r2 - 1.0 / 6.0; sp = sp * r2 * r + r;
    double cp = 1.0 / 20922789888000.0; cp = cp * r2 - 1.0 / 87178291200.0; cp = cp * r2 + 1.0 / 479001600.0; cp = cp * r2 - 1.0 / 3628800.0; cp = cp * r2 + 1.0 / 40320.0; cp = cp * r2 - 1.0 / 720.0; cp = cp * r2 + 1.0 / 24.0; cp = cp * r2 - 0.5; cp = cp * r2 + 1.0;
    const int k = ((int)kd) & 3;
    s = (k == 0) ? sp : (k == 1) ? cp : (k == 2) ? -sp : -cp;
    c = (k == 0) ? cp : (k == 1) ? -sp : (k == 2) ? -cp : sp;
}
__device__ __forceinline__ float silu_f(float a) { return a / (1.0f + __expf(-a)); }

__device__ __forceinline__ void ssm_disc(double dt, float are_f, float aim_f, double& abr, double& abi, double& cfr, double& cfi) {
    const double are = (double)are_f, aim = (double)aim_f, mag = exp(dt * are); double s, c; dsincos(dt * aim, s, c);
    abr = mag * c; abi = mag * s; const double den = are * are + aim * aim, nr = abr - 1.0;
    cfr = (nr * are + abi * aim) / den; cfi = (abi * are - nr * aim) / den;
}
__device__ __forceinline__ void p0_transpose_item(const float* W, int K, int N, bf16* WT, int mode, LAS float* scr, int item, int lane) {
    const int nblk = N / 32, kb = item / nblk, nb = item % nblk, k0 = 64 * kb, n0 = 32 * nb;
#pragma unroll 8
    for (int i = 0; i < 32; ++i) { const int kk = 2 * i + (lane >> 5); scr[kk * 33 + (lane & 31)] = W[(size_t)(k0 + kk) * N + n0 + (lane & 31)]; }
    LDS_WAIT(); asm volatile("" ::: "memory");
    const int c = lane & 7;
#pragma unroll
    for (int j = 0; j < 4; ++j) { const int n = (lane >> 3) + 8 * j; const LAS float* s = scr + (8 * c) * 33 + n;
        v4u o; o.x = pk2(s[0 * 33], s[1 * 33]); o.y = pk2(s[2 * 33], s[3 * 33]); o.z = pk2(s[4 * 33], s[5 * 33]); o.w = pk2(s[6 * 33], s[7 * 33]);
        const int ns = n0 + n; const int drow = (mode == 0) ? ns : ((ns >> 7) * 256 + (mode - 1) * 128 + (ns & 127));
        *(GAS v4u*)(WT + (size_t)drow * K + k0 + 8 * c) = o; }
    LDS_WAIT(); asm volatile("" ::: "memory");
}
constexpr int I_FF1 = (D / 64) * (DFF / 32), I_FF2 = (DFF / 64) * (D / 32), I_IN = (D / 64) * (DIN / 32), I_OUT = (D / 64) * (D / 32), I_GLU = (WSSM / 64) * (WSSM / 32);
constexpr int I_LAYER = 4 * I_FF1 + 2 * I_FF2 + I_IN + I_OUT + I_GLU;
constexpr int SUPER = 64, N_SUPER = 2 * I_LAYER / SUPER;
static_assert((2 * I_LAYER) % SUPER == 0, "super-items");
constexpr int GEMV_COLS = 128, N_GEMV = 2 * (MODW / GEMV_COLS);
__device__ __forceinline__ void p0_convert_item(Frame& F, int it, LAS float* scr) {
    const int l = it / I_LAYER; int r = it % I_LAYER;
    unsigned char* wl = F.ws + WS_W + (size_t)l * W_LAYER;
    if (r < I_FF1) { p0_transpose_item(FIN(6) + (size_t)l * D * DFF, D, DFF, (bf16*)(wl + WL_13A), 1, scr, r, F.lane); return; } r -= I_FF1;
    if (r < I_FF1) { p0_transpose_item(FIN(7) + (size_t)l * D * DFF, D, DFF, (bf16*)(wl + WL_13A), 2, scr, r, F.lane); return; } r -= I_FF1;
    if (r < I_FF2) { p0_transpose_item(FIN(8) + (size_t)l * D * DFF, DFF, D, (bf16*)(wl + WL_2A), 0, scr, r, F.lane); return; } r -= I_FF2;
    if (r < I_FF1) { p0_transpose_item(FIN(9) + (size_t)l * D * DFF, D, DFF, (bf16*)(wl + WL_13B), 1, scr, r, F.lane); return; } r -= I_FF1;
    if (r < I_FF1) { p0_transpose_item(FIN(10) + (size_t)l * D * DFF, D, DFF, (bf16*)(wl + WL_13B), 2, scr, r, F.lane); return; } r -= I_FF1;
    if (r < I_FF2) { p0_transpose_item(FIN(11) + (size_t)l * D * DFF, DFF, D, (bf16*)(wl + WL_2B), 0, scr, r, F.lane); return; } r -= I_FF2;
    if (r < I_IN) { p0_transpose_item(FIN(12) + (size_t)l * D * DIN, D, DIN, (bf16*)(wl + WL_IN), 0, scr, r, F.lane); return; } r -= I_IN;
    if (r < I_OUT) { p0_transpose_item(FIN(13) + (size_t)l * D * D, D, D, (bf16*)(wl + WL_OUT), 0, scr, r, F.lane); return; } r -= I_OUT;
    p0_transpose_item(FIN(28) + (size_t)l * WSSM * WSSM, WSSM, WSSM, (bf16*)(wl + WL_GLU), 0, scr, r, F.lane);
}
__device__ __forceinline__ void p0_gemv_task(Frame& F, int t) {
    const int l = t / (MODW / GEMV_COLS), cb = t % (MODW / GEMV_COLS), col0 = cb * GEMV_COLS;
    const LAS float* sil = (const LAS float*)(F.lds + P0_SIL_OFF);
    LAS float* red = (LAS float*)(F.lds + P0_RED_OFF);
    typedef float f32x2 __attribute__((ext_vector_type(2)));
    const float* wp = FIN(4) + ((size_t)l * D + (size_t)F.wave * 512) * MODW + col0 + 2 * F.lane;
    f32x2 a0 = {0.f, 0.f}, a1 = {0.f, 0.f}, a2 = {0.f, 0.f};
    const int kb = F.wave * 512;
#pragma unroll 8
    for (int k = 0; k < 512; ++k) { const f32x2 w = *(const GAS f32x2*)(wp + (size_t)k * MODW);
        a0 += w * sil[kb + k]; a1 += w * sil[D + kb + k]; a2 += w * sil[2 * D + kb + k]; }
    red[(F.wave * 3 + 0) * GEMV_COLS + 2 * F.lane] = a0.x; red[(F.wave * 3 + 0) * GEMV_COLS + 2 * F.lane + 1] = a0.y;
    red[(F.wave * 3 + 1) * GEMV_COLS + 2 * F.lane] = a1.x; red[(F.wave * 3 + 1) * GEMV_COLS + 2 * F.lane + 1] = a1.y;
    red[(F.wave * 3 + 2) * GEMV_COLS + 2 * F.lane] = a2.x; red[(F.wave * 3 + 2) * GEMV_COLS + 2 * F.lane + 1] = a2.y;
    __syncthreads();
    if (F.tid < 3 * GEMV_COLS) { const int v = F.tid / GEMV_COLS, j = F.tid % GEMV_COLS; float s = 0.f;
#pragma unroll
        for (int w = 0; w < 8; ++w) s += red[(w * 3 + v) * GEMV_COLS + j];
        WSP(float, WS_MOD)[((size_t)l * 3 + v) * MODW + col0 + j] = s + FIN(5)[(size_t)l * MODW + col0 + j]; }
    __syncthreads();
}
__device__ __forceinline__ void p0_prologue(Frame& F) {
    LAS float* sil = (LAS float*)(F.lds + P0_SIL_OFF);
    for (int i = F.tid; i < 3 * D; i += NWAVES * 64) { const float cv = (i < 2 * D) ? FIN(1)[i] : FIN(3)[i - 2 * D]; sil[i] = silu_f(cv); }
    if (blockIdx.x == 0) {
        for (int i = F.tid; i < 128 * 16; i += NWAVES * 64) { const int pos = i >> 4, k = i & 15;
            const float inv = (float)exp(-(double)k * (9.210340371976184 / 16.0));
            const float ang = (float)pos * inv; double s, c; dsincos((double)ang, s, c);
            WSP(float, WS_ROPE)[pos * 32 + k] = (float)c; WSP(float, WS_ROPE)[pos * 32 + 16 + k] = (float)s; }
    }
    for (int pg = blockIdx.x; pg < 256; pg += F.G) if (F.tid < 64) { const int n = F.tid;
        const double dt = exp((double)FIN(22)[pg]); double abr, abi, cr, ci; ssm_disc(dt, FIN(20)[pg * 64 + n], FIN(21)[pg * 64 + n], abr, abi, cr, ci);
        WSP(float, WS_ABAR)[(pg * 64 + n) * 2] = (float)abr; WSP(float, WS_ABAR)[(pg * 64 + n) * 2 + 1] = (float)abi;
        const float* bre = FIN(23) + ((size_t)pg * 64 + n) * 16; const float* bim = FIN(24) + ((size_t)pg * 64 + n) * 16;
#pragma unroll 4
        for (int p = 0; p < 16; ++p) { WSP(float, WS_BBR)[((size_t)pg * 64 + n) * 16 + p] = (float)(cr * (double)bre[p] - ci * (double)bim[p]);
                                       WSP(float, WS_BBI)[((size_t)pg * 64 + n) * 16 + p] = (float)(cr * (double)bim[p] + ci * (double)bre[p]); } }
    __syncthreads();
    LAS float* scr = (LAS float*)(F.lds + F.wave * 8448);
    LAS unsigned* qslot = (LAS unsigned*)(F.lds + P0_Q_OFF);
    for (;;) {
        if (F.tid == 0) qslot[0] = __hip_atomic_fetch_add(F.ctl + CW_QUEUE, 1u, RLX_AGENT);
        __syncthreads();
        const int t = (int)qslot[0];
        __syncthreads();
        if (t >= N_GEMV + N_SUPER) break;
        if (t < N_GEMV) p0_gemv_task(F, t);
        else { const int base = (t - N_GEMV) * SUPER;
#pragma unroll 1
            for (int i = 0; i < SUPER / NWAVES; ++i) p0_convert_item(F, base + i * NWAVES + F.wave, scr); }
    }
}

__device__ __forceinline__ const float* xrow_ptr(const float* lat, const float* cx, int row) { return row < NLAT ? lat + (size_t)row * D : cx + (size_t)(row - NLAT) * D; }
__device__ __forceinline__ void norm_mod_phase(Frame& F, const float* lat, const float* cx, int nrows, const float* modl, int ish, int isc, bf16* H) {
    const int gw = F.vcu * NWAVES + F.wave, NGW = F.G * NWAVES;
    for (int row = gw; row < nrows; row += NGW) {
        const GAS f32x4* xr = (const GAS f32x4*)xrow_ptr(lat, cx, row) + F.lane;
        const int set = row < 8192 ? 0 : (row < NLAT ? 1 : 2);
        const GAS f32x4* sh = (const GAS f32x4*)(modl + (size_t)set * MODW + ish * D) + F.lane;
        const GAS f32x4* sc = (const GAS f32x4*)(modl + (size_t)set * MODW + isc * D) + F.lane;
        f32x4 v[16]; float ss = 0.f;
#pragma unroll
        for (int j = 0; j < 16; ++j) { v[j] = xr[64 * j]; ss += (v[j].x * v[j].x + v[j].y * v[j].y) + (v[j].z * v[j].z + v[j].w * v[j].w); }
        const float r = 1.0f / sqrtf(wave_sum(ss) * (1.0f / D) + NORM_EPS);
        GAS unsigned long long* o8 = (GAS unsigned long long*)(H + (size_t)row * D) + F.lane;
#pragma unroll
        for (int j = 0; j < 16; ++j) { const f32x4 s4 = sc[64 * j], h4 = sh[64 * j]; const f32x4 y = v[j] * r * (s4 + 1.0f) + h4;
            o8[64 * j] = (unsigned long long)pk2(y.x, y.y) | ((unsigned long long)pk2(y.z, y.w) << 32); }
    }
}
__device__ __forceinline__ void final_norm_phase(Frame& F) {
    const int gw = F.vcu * NWAVES + F.wave, NGW = F.G * NWAVES;
    const GAS f32x4* gp = (const GAS f32x4*)FIN(29) + F.lane;
    for (int row = gw; row < NLAT; row += NGW) {
        const GAS f32x4* xr = (const GAS f32x4*)(WSP(float, WS_X) + (size_t)row * D) + F.lane;
        f32x4 v[16]; float ss = 0.f;
#pragma unroll
        for (int j = 0; j < 16; ++j) { v[j] = xr[64 * j]; ss += (v[j].x * v[j].x + v[j].y * v[j].y) + (v[j].z * v[j].z + v[j].w * v[j].w); }
        const float r = 1.0f / sqrtf(wave_sum(ss) * (1.0f / D) + NORM_EPS);
        GAS f32x4* o = (GAS f32x4*)(F.out + (size_t)row * D) + F.lane;
#pragma unroll
        for (int j = 0; j < 16; ++j) o[64 * j] = v[j] * r * gp[64 * j];
    }
}
__device__ __forceinline__ void unpack8(const v4u w, float (&f)[8]) {
    f[0] = pg8::bf_lo(w.x); f[1] = pg8::bf_hi(w.x); f[2] = pg8::bf_lo(w.y); f[3] = pg8::bf_hi(w.y); f[4] = pg8::bf_lo(w.z); f[5] = pg8::bf_hi(w.z); f[6] = pg8::bf_lo(w.w); f[7] = pg8::bf_hi(w.w);
}
__device__ __forceinline__ void conv_phase(Frame& F, int l, int nrows) {
    const int gw = F.vcu * NWAVES + F.wave, NGW = F.G * NWAVES;
    const bf16* P = WSP(bf16, WS_P); bf16* YC = WSP(bf16, WS_YCAT);
    const float* cw = FIN(14) + (size_t)l * 3 * WCONV;
    for (int row = gw; row < nrows; row += NGW) {
        int t, len; if (row < NLAT) { t = row & 8191; len = 8192; } else { t = (row - NLAT) & 255; len = 256; }
        const bool hp = t > 0, hn = t + 1 < len;
#pragma unroll
        for (int hv = 0; hv < 2; ++hv) { const int c0 = F.lane * 16 + hv * 8;
            const bf16* p0 = P + (size_t)row * LDP + c0;
            float h0[8], b0[8], g0[8], hm[8], gm[8], hq[8], gq[8];
            unpack8(*(const GAS v4u*)(p0), h0); unpack8(*(const GAS v4u*)(p0 + WCONV), b0); unpack8(*(const GAS v4u*)(p0 + 2 * WCONV), g0);
            if (hp) { unpack8(*(const GAS v4u*)(p0 - LDP), hm); unpack8(*(const GAS v4u*)(p0 - LDP + 2 * WCONV), gm); }
            if (hn) { unpack8(*(const GAS v4u*)(p0 + LDP), hq); unpack8(*(const GAS v4u*)(p0 + LDP + 2 * WCONV), gq); }
            float o[8];
#pragma unroll
            for (int x = 0; x < 8; ++x) { const float zm = hp ? gm[x] * hm[x] : 0.f, z0 = g0[x] * h0[x], zq = hn ? gq[x] * hq[x] : 0.f;
                o[x] = b0[x] * (zm * cw[c0 + x] + z0 * cw[WCONV + c0 + x] + zq * cw[2 * WCONV + c0 + x]); }
            v4u w; w.x = pk2(o[0], o[1]); w.y = pk2(o[2], o[3]); w.z = pk2(o[4], o[5]); w.w = pk2(o[6], o[7]);
            *(GAS v4u*)(YC + (size_t)row * D + c0) = w; }
    }
}
__device__ __forceinline__ float gelu_tanh(float y) { const float u = 1.5957691216057308f * (y + 0.044715f * y * y * y); return y / (1.0f + __expf(-u)); }
__device__ __forceinline__ void ssm_combine_phase(Frame& F, int l, int nrows) {
    const bf16* P = WSP(bf16, WS_P); const float* YF = WSP(float, WS_YF); const float* YR = WSP(float, WS_YR); bf16* YP = WSP(bf16, WS_YPRE);
    const float* dsk = FIN(27) + (size_t)l * WSSM;
    const size_t total = (size_t)nrows * (WSSM / 8), stride = (size_t)F.G * NWAVES * 64;
    for (size_t i = (size_t)F.vcu * NWAVES * 64 + F.tid; i < total; i += stride) { const size_t row = i >> 7; const int c = (int)(i & 127) * 8;
        float u[8]; unpack8(*(const GAS v4u*)(P + row * LDP + OFF_U + c), u);
        const f32x4 f0 = *(const GAS f32x4*)(YF + row * WSSM + c), f1 = *(const GAS f32x4*)(YF + row * WSSM + c + 4);
        const f32x4 r0 = *(const GAS f32x4*)(YR + row * WSSM + c), r1 = *(const GAS f32x4*)(YR + row * WSSM + c + 4);
        const f32x4 d0 = *(const GAS f32x4*)(dsk + c), d1 = *(const GAS f32x4*)(dsk + c + 4);
        float y[8];
        y[0] = d0.x * u[0] + f0.x + r0.x; y[1] = d0.y * u[1] + f0.y + r0.y; y[2] = d0.z * u[2] + f0.z + r0.z; y[3] = d0.w * u[3] + f0.w + r0.w;
        y[4] = d1.x * u[4] + f1.x + r1.x; y[5] = d1.y * u[5] + f1.y + r1.y; y[6] = d1.z * u[6] + f1.z + r1.z; y[7] = d1.w * u[7] + f1.w + r1.w;
#pragma unroll
        for (int x = 0; x < 8; ++x) y[x] = gelu_tanh(y[x]);
        v4u w; w.x = pk2(y[0], y[1]); w.y = pk2(y[2], y[3]); w.z = pk2(y[4], y[5]); w.w = pk2(y[6], y[7]);
        *(GAS v4u*)(YP + row * WSSM + c) = w; }
}

__device__ __forceinline__ int ssm_row(int si, int dir, int b) {
    if (si < CTXL) return NLAT + b * CTXL + (dir ? CTXL - 1 - si : si);
    const int li = si - CTXL; return b * SEQ + (dir ? SEQ - 1 - li : li);
}
__device__ __forceinline__ void split8(const float (&v)[8], bf16x8& hi8, bf16x8& lo8) {
    v4u h, lo; float rs[8];
    h.x = pg8::cvt_pk_bf16(v[0], v[1]); h.y = pg8::cvt_pk_bf16(v[2], v[3]); h.z = pg8::cvt_pk_bf16(v[4], v[5]); h.w = pg8::cvt_pk_bf16(v[6], v[7]);
    rs[0] = v[0] - pg8::bf_lo(h.x); rs[1] = v[1] - pg8::bf_hi(h.x); rs[2] = v[2] - pg8::bf_lo(h.y); rs[3] = v[3] - pg8::bf_hi(h.y);
    rs[4] = v[4] - pg8::bf_lo(h.z); rs[5] = v[5] - pg8::bf_hi(h.z); rs[6] = v[6] - pg8::bf_lo(h.w); rs[7] = v[7] - pg8::bf_hi(h.w);
    lo.x = pg8::cvt_pk_bf16(rs[0], rs[1]); lo.y = pg8::cvt_pk_bf16(rs[2], rs[3]); lo.z = pg8::cvt_pk_bf16(rs[4], rs[5]); lo.w = pg8::cvt_pk_bf16(rs[6], rs[7]);
    hi8 = __builtin_bit_cast(bf16x8, h); lo8 = __builtin_bit_cast(bf16x8, lo);
}
__device__ __forceinline__ int crow16(int r, int hi) { return (r & 3) + 8 * (r >> 2) + 4 * hi; }
__device__ __forceinline__ void ssm_task(Frame& F, int l, int task) {
    typedef float f32x16 __attribute__((ext_vector_type(16)));
    constexpr int NCH = (CTXL + SEQ) / 64, HS = 132;
    const int b = task >> 7, dir = (task >> 6) & 1, g = task & 63, pg = (l * 2 + dir) * 64 + g;
    const int w = F.wave, lane = F.lane, r32 = lane & 31, hi = lane >> 5, fr = lane & 15, fq = lane >> 4;
    LAS float* BU = (LAS float*)(F.lds);
    LAS float* HB = (LAS float*)(F.lds + 65536);
    const bf16* P = WSP(bf16, WS_P); float* Yout = dir ? WSP(float, WS_YR) : WSP(float, WS_YF);
    float ar = 0.f, ai = 0.f, hr = 0.f, hi_ = 0.f;
    bf16x8 Bh[4], Bl[4];
    bf16x8 Ch[4], Cl[4];
    v4u an0 = {0u, 0u, 0u, 0u}, an1 = {0u, 0u, 0u, 0u};
#pragma unroll
    for (int q = 0; q < 4; ++q) { Bh[q] = bf16x8{}; Bl[q] = bf16x8{}; Ch[q] = bf16x8{}; Cl[q] = bf16x8{}; }
    if (w == 0) { ar = WSP(float, WS_ABAR)[(pg * 64 + lane) * 2]; ai = WSP(float, WS_ABAR)[(pg * 64 + lane) * 2 + 1]; }
    else if (w <= 4) {
        const float* cre = FIN(25) + ((size_t)pg * 16 + fr) * 64; const float* cim = FIN(26) + ((size_t)pg * 16 + fr) * 64;
#pragma unroll
        for (int ks = 0; ks < 4; ++ks) { float v[8];
#pragma unroll
            for (int x = 0; x < 8; ++x) { const int nn = 32 * ks + 8 * fq + x; v[x] = (ks < 2) ? cre[nn] : -cim[nn - 64]; }
            split8(v, Ch[ks], Cl[ks]); }
    } else {
#pragma unroll
        for (int nb = 0; nb < 4; ++nb) { const int n = 32 * (nb & 1) + r32;
            const float* bb = ((nb < 2) ? WSP(float, WS_BBR) : WSP(float, WS_BBI)) + ((size_t)pg * 64 + n) * 16 + 8 * hi; float v[8];
#pragma unroll
            for (int x = 0; x < 8; ++x) v[x] = bb[x];
            split8(v, Bh[nb], Bl[nb]); }
        an0 = *(const GAS v4u*)(P + (size_t)ssm_row(r32, dir, b) * LDP + OFF_U + 16 * g + 8 * hi);
        an1 = *(const GAS v4u*)(P + (size_t)ssm_row(32 + r32, dir, b) * LDP + OFF_U + 16 * g + 8 * hi);
    }
    __syncthreads();
    for (int c = -1; c <= NCH; ++c) {
        if (w == 0) {
            if (c >= 0 && c < NCH) { const LAS float* bu = BU + (c & 1) * (64 * 128) + lane; LAS float* hb = HB + (c & 1) * (64 * HS) + lane;
#pragma unroll 16
                for (int s = 0; s < 64; ++s) { const float br = bu[s * 128], bi = bu[s * 128 + 64];
                    const float nhr = fmaf(ar, hr, fmaf(-ai, hi_, br)), nhi = fmaf(ar, hi_, fmaf(ai, hr, bi)); hr = nhr; hi_ = nhi;
                    hb[s * HS] = hr; hb[s * HS + 64] = hi_; } }
        } else if (w <= 4) {
            if (c >= 1) { const int ch = c - 1, rb = w - 1; const LAS float* hrow = HB + (ch & 1) * (64 * HS) + (16 * rb + fr) * HS + 8 * fq;
                f32x4 acc = {0.f, 0.f, 0.f, 0.f};
#pragma unroll
                for (int ks = 0; ks < 4; ++ks) { const f32x4 x0 = *(const LAS f32x4*)(hrow + 32 * ks), x1 = *(const LAS f32x4*)(hrow + 32 * ks + 4);
                    const float v[8] = {x0.x, x0.y, x0.z, x0.w, x1.x, x1.y, x1.z, x1.w}; bf16x8 Hh, Hl; split8(v, Hh, Hl);
                    acc = __builtin_amdgcn_mfma_f32_16x16x32_bf16(Ch[ks], Hh, acc, 0, 0, 0);
                    acc = __builtin_amdgcn_mfma_f32_16x16x32_bf16(Cl[ks], Hh, acc, 0, 0, 0);
                    acc = __builtin_amdgcn_mfma_f32_16x16x32_bf16(Ch[ks], Hl, acc, 0, 0, 0); }
                const int row = ssm_row(64 * ch + 16 * rb + fr, dir, b);
                *(GAS f32x4*)(Yout + (size_t)row * WSSM + 16 * g + 4 * fq) = acc; }
        } else {
            if (c + 1 < NCH) { const int ch = c + 1; const bf16x8 a0 = __builtin_bit_cast(bf16x8, an0), a1 = __builtin_bit_cast(bf16x8, an1);
                if (ch + 1 < NCH) { an0 = *(const GAS v4u*)(P + (size_t)ssm_row(64 * (ch + 1) + r32, dir, b) * LDP + OFF_U + 16 * g + 8 * hi);
                                    an1 = *(const GAS v4u*)(P + (size_t)ssm_row(64 * (ch + 1) + 32 + r32, dir, b) * LDP + OFF_U + 16 * g + 8 * hi); }
                LAS float* buw = BU + (ch & 1) * (64 * 128);
#pragma unroll
                for (int ti = 0; ti < 8; ++ti) if (ti / 3 == w - 5) { const int sb = ti >> 2, nb = ti & 3;
                    f32x16 d = {}; d = __builtin_amdgcn_mfma_f32_32x32x16_bf16(sb ? a1 : a0, Bh[nb], d, 0, 0, 0); d = __builtin_amdgcn_mfma_f32_32x32x16_bf16(sb ? a1 : a0, Bl[nb], d, 0, 0, 0);
                    LAS float* dst = buw + (32 * sb) * 128 + 32 * nb + r32;
#pragma unroll
                    for (int r = 0; r < 16; ++r) dst[crow16(r, hi) * 128] = d[r]; } }
        }
        __syncthreads();
    }
}

struct Args { const float* in[NIN]; float* out; unsigned char* ws; int ph_lo, ph_hi; };
constexpr int N_PHASES = 26;
__global__ void __launch_bounds__(NWAVES * 64, 2) fwd_kernel(Args args) {
    extern __shared__ __attribute__((aligned(16))) unsigned char lds[];
    Frame F;
    F.lds = (LAS unsigned char*)lds;
    F.MISC = (volatile LAS unsigned*)(F.lds + MISC_OFF);
    F.tid = threadIdx.x; F.lane = F.tid & 63; F.wave = __builtin_amdgcn_readfirstlane(F.tid >> 6);
    F.G = gridDim.x; { const int bx = blockIdx.x; F.vcu = (F.G % 8 == 0) ? (bx % 8) * (F.G / 8) + bx / 8 : bx; }
    F.ws = args.ws; F.out = args.out; F.ctl = (gu32*)(args.ws + WS_CTL); F.kp = __builtin_amdgcn_kernarg_segment_ptr();
#define PHASE_ENTER() do { int t_ = threadIdx.x; asm volatile("" : "+v"(t_)); F.tid = t_; F.lane = t_ & 63; F.wave = __builtin_amdgcn_readfirstlane(t_ >> 6); \
        kargp_t k_ = __builtin_amdgcn_kernarg_segment_ptr(); asm volatile("" : "+s"(k_)); F.kp = k_; } while (0)
    for (int u = F.tid; u < (LDS_BYTES - LDSCTL_OFF) / 4; u += NWAVES * 64) ((LAS unsigned*)(F.lds + LDSCTL_OFF))[u] = 0u;
    __syncthreads();
    const int lo = args.ph_lo, hi = args.ph_hi;
    XcdBarrier bar; bar.bar = (unsigned*)(F.ctl + CW_BAR); bar.x = 0; bar.st = nullptr;
    if (hi - lo > 1) bar = xcd_barrier_post((unsigned*)(F.ctl + CW_BAR), F.MISC + 8);
#define IN(k) (lo <= (k) && (k) < hi)
#define INP(k) (IN(k) && ({ PHASE_ENTER(); true; }))
#define SEAM(k) do { if (IN(k) && IN((k) + 1)) xcd_barrier(bar); } while (0)

    #ifndef SKIP_P0
    if (INP(0)) p0_prologue(F);
#endif
    SEAM(0);

    float* X = WSP(float, WS_X); bf16* H = WSP(bf16, WS_H); bf16* HID = WSP(bf16, WS_HID); bf16* P = WSP(bf16, WS_P); bf16* YC = WSP(bf16, WS_YCAT); bf16* YP = WSP(bf16, WS_YPRE);
    for (int blk = 0; blk < 6; ++blk) {
        const int l = blk / 3, kind = blk % 3;
        const float* modl = WSP(float, WS_MOD) + (size_t)l * 3 * MODW;
        unsigned char* wl = F.ws + WS_W + (size_t)l * W_LAYER;
        if (kind != 1) {
            const int pb = 1 + 12 * l + (kind == 2 ? 9 : 0);
            const int Mx = (blk == 5) ? NLAT : MROWS;
            const bool first = (blk == 0);
            const float* xl = first ? FIN(0) : X; const float* xc = first ? FIN(2) : X + (size_t)NLAT * D;
            const int im = (kind == 0) ? 0 : 6;
#ifndef SKIP_NORM
            if (INP(pb)) norm_mod_phase(F, xl, xc, Mx, modl, im, im + 1, H);
#endif
            SEAM(pb);
#ifndef SKIP_G1
            if (INP(pb + 1)) { pg8::Gemm g{H, (const bf16*)(wl + (kind == 0 ? WL_13A : WL_13B)), Mx, 2 * DFF, D}; pg8::StaticOrder S; S.init(Mx, 2 * DFF, F.G, (int)blockIdx.x);
                pg8::EpiSwiGLU E{HID, DFF};
                pg8::gemm_phase<pg8::EpiSwiGLU, pg8::StaticOrder, true, true>(F.lds, g, S, E); }
#endif
            SEAM(pb + 1);
#ifndef SKIP_G2
            if (INP(pb + 2)) { pg8::Gemm g{HID, (const bf16*)(wl + (kind == 0 ? WL_2A : WL_2B)), Mx, D, DFF}; pg8::StaticOrder S; S.init(Mx, D, F.G, (int)blockIdx.x);
                pg8::EpiResid E{xl, xc, X, modl + (im + 2) * D, 0.5f};
                pg8::gemm_phase<pg8::EpiResid, pg8::StaticOrder, true, true>(F.lds, g, S, E); }
#endif
            SEAM(pb + 2);
        } else {
            const int pb = 1 + 12 * l + 3;
            const int Mo = (l == 1) ? NLAT : MROWS;
#ifndef SKIP_NORM
            if (INP(pb)) norm_mod_phase(F, X, X + (size_t)NLAT * D, MROWS, modl, 3, 4, H);
#endif
            SEAM(pb);
#ifndef SKIP_G3
            if (INP(pb + 1)) { pg8::Gemm g{H, (const bf16*)(wl + WL_IN), MROWS, DIN, D}; pg8::StaticOrder S; S.init(MROWS, DIN, F.G, (int)blockIdx.x);
                pg8::EpiRope E{P, DIN, WSP(float, WS_ROPE)};
                pg8::gemm_phase<pg8::EpiRope, pg8::StaticOrder, true, true>(F.lds, g, S, E); }
#endif
            SEAM(pb + 1);
            if (INP(pb + 2)) {
#ifndef SKIP_SSM
                for (int t = blockIdx.x; t < 256; t += F.G) ssm_task(F, l, t);
#endif
#ifndef SKIP_CONV
                conv_phase(F, l, Mo);
#endif
            }
            SEAM(pb + 2);
#ifndef SKIP_COMB
            if (INP(pb + 3)) ssm_combine_phase(F, l, Mo);
#endif
            SEAM(pb + 3);
            if (INP(pb + 4)) {
#ifndef SKIP_ATT
                const float d1 = wave_sum(FIN(15)[l * 64 + F.lane] * FIN(16)[l * 64 + F.lane]), d2 = wave_sum(FIN(17)[l * 64 + F.lane] * FIN(18)[l * 64 + F.lane]);
                const float lam_init = (l == 0) ? 0.2f : 0.355509067590969f;
                att::AttnArgs A{P, YC, FIN(19) + l * 128, __expf(d1) - __expf(d2) + lam_init, 1.0f - lam_init};
                const int nunits = (l == 0) ? 2048 + 64 : 2048;
                for (int e = F.vcu; e < nunits; e += F.G) {
                    if (e < 2048) { const int bh = e >> 6, qb = e & 63, b = bh >> 4, h = bh & 15;
                        att::attn_unit(A, b * SEQ + qb * 128, h, b * SEQ, SEQ / 64, NLAT + b * CTXL, (SEQ + CTXL) / 64, (char*)lds); }
                    else { const int e2 = e - 2048, bh = e2 >> 1, qb = e2 & 1, b = bh >> 4, h = bh & 15;
                        att::attn_unit(A, NLAT + b * CTXL + qb * 128, h, 0, 0, NLAT + b * CTXL, CTXL / 64, (char*)lds); }
                }
#endif
#ifndef SKIP_GLU
                pg8::Gemm g{YP, (const bf16*)(wl + WL_GLU), Mo, WSSM, WSSM}; pg8::StaticOrder S; S.init(Mo, WSSM, F.G, (int)blockIdx.x);
                pg8::EpiGlu E{YP, WSSM, YC, D, WCONV + WATT};
                pg8::gemm_phase<pg8::EpiGlu, pg8::StaticOrder, true, true>(F.lds, g, S, E);
#endif
            }
            SEAM(pb + 4);
#ifndef SKIP_G4
            if (INP(pb + 5)) { pg8::Gemm g{YC, (const bf16*)(wl + WL_OUT), Mo, D, D}; pg8::StaticOrder S; S.init(Mo, D, F.G, (int)blockIdx.x);
                pg8::EpiResid E{X, X + (size_t)NLAT * D, X, modl + 5 * D, 1.0f};
                pg8::gemm_phase<pg8::EpiResid, pg8::StaticOrder, true, true>(F.lds, g, S, E); }
#endif
            SEAM(pb + 5);
        }
    }
#ifndef SKIP_FIN
    if (INP(25)) final_norm_phase(F);
#endif
#undef IN
#undef SEAM
}

#ifndef MK_ONE_LAUNCH
#define MK_ONE_LAUNCH 1
#endif
extern "C" void kernel_launch(void* const* d_in, const int* in_sizes, int n_in, void* d_out, int out_size, void* d_ws, size_t ws_size, hipStream_t stream) {
    static int grid = 0;
    if (grid == 0) {
        if (n_in != NIN || in_sizes[0] != NLAT * D || out_size != NLAT * D || ws_size < WS_END) {
            fprintf(stderr, "kernel_launch: shape mismatch: n_in %d in0 %d out %d ws %zu (need %zu)\n", n_in, n_in > 0 ? in_sizes[0] : -1, out_size, ws_size, (size_t)WS_END); grid = -1; return; }
        int dev = 0, cus = 0, per_cu = 0;
        if (hipGetDevice(&dev) != hipSuccess || hipDeviceGetAttribute(&cus, hipDeviceAttributeMultiprocessorCount, dev) != hipSuccess) { fprintf(stderr, "kernel_launch: device query failed\n"); grid = -1; return; }
        if (hipFuncSetAttribute((const void*)fwd_kernel, hipFuncAttributeMaxDynamicSharedMemorySize, LDS_BYTES) != hipSuccess) { fprintf(stderr, "kernel_launch: hipFuncSetAttribute failed\n"); grid = -1; return; }
        if (hipOccupancyMaxActiveBlocksPerMultiprocessor(&per_cu, (const void*)fwd_kernel, NWAVES * 64, LDS_BYTES) != hipSuccess || per_cu < 1)
            fprintf(stderr, "kernel_launch: note: occupancy query reports %d workgroups per CU\n", per_cu);
        (void)hipGetLastError();
        grid = cus;
    }
    if (grid < 0) return;
    if (hipMemsetAsync((char*)d_ws + WS_CTL, 0, CTL_ZERO_BYTES, stream) != hipSuccess) { fprintf(stderr, "kernel_launch: memset failed\n"); return; }
    Args a{};
    for (int i = 0; i < NIN; ++i) a.in[i] = (const float*)d_in[i];
    a.out = (float*)d_out; a.ws = (unsigned char*)d_ws;
#if MK_ONE_LAUNCH
    a.ph_lo = 0; a.ph_hi = N_PHASES;
    hipLaunchKernelGGL(fwd_kernel, dim3(grid), dim3(NWAVES * 64), LDS_BYTES, stream, a);
#else
    for (int p = 0; p < N_PHASES; ++p) { a.ph_lo = p; a.ph_hi = p + 1;
        hipLaunchKernelGGL(fwd_kernel, dim3(grid), dim3(NWAVES * 64), LDS_BYTES, stream, a); }
#endif
    const hipError_t le = hipPeekAtLastError();
    if (le != hipSuccess) fprintf(stderr, "kernel_launch: launch failed: %s\n", hipGetErrorName(le));
}
```

```cpp
#include <hip/hip_runtime.h>
#include <hip/hip_bf16.h>
#include <cstdio>
#include <cstdint>
#include <cstddef>
#include <cmath>
constexpr int NIN = 30;
constexpr int D = 4096, BATCH = 2, SEQ = 8192, CTXL = 256, DFF = 8192, NLAT = BATCH * SEQ, NCTX = BATCH * CTXL, MROWS = NLAT + NCTX;
constexpr int WCONV = 1024, WATT = 2048, WSSM = 1024, DIN = 10240, LDP = DIN, OFF_U = 9216, MODW = 9 * D;
constexpr float NORM_EPS = 1e-6f;
constexpr int NWAVES = 8;
constexpr size_t MiB = 1u << 20;
constexpr size_t WS_CTL = 0, CTL_ZERO_BYTES = 1 * MiB;
constexpr size_t WS_MOD = 1 * MiB;
constexpr size_t WS_ROPE = 2 * MiB;
constexpr size_t WS_W = 4 * MiB, W_LAYER = 498 * MiB;
constexpr size_t WL_13A = 0, WL_2A = 128 * MiB, WL_13B = 192 * MiB, WL_2B = 320 * MiB, WL_IN = 384 * MiB, WL_OUT = 464 * MiB, WL_GLU = 496 * MiB;
constexpr size_t WS_X = 1000 * MiB;
constexpr size_t WS_H = 1264 * MiB;
constexpr size_t WS_HID = 1396 * MiB;
constexpr size_t WS_P = 1660 * MiB;
constexpr size_t WS_YCAT = 1990 * MiB;
constexpr size_t WS_YF = 2122 * MiB, WS_YR = 2188 * MiB;
constexpr size_t WS_YPRE = 2254 * MiB;
constexpr size_t WS_ABAR = 2287 * MiB;
constexpr size_t WS_BBR = 2288 * MiB, WS_BBI = 2289 * MiB;
constexpr size_t WS_PART = 2290 * MiB;
constexpr size_t WS_END = 2354 * MiB;
static_assert(WS_W + 2 * W_LAYER <= WS_X && WS_X + (size_t)MROWS * D * 4 <= WS_H && WS_H + (size_t)MROWS * D * 2 <= WS_HID && WS_HID + (size_t)MROWS * DFF * 2 <= WS_P &&
              WS_P + (size_t)MROWS * DIN * 2 <= WS_YCAT && WS_YCAT + (size_t)MROWS * D * 2 <= WS_YF && WS_YF + (size_t)MROWS * WSSM * 4 <= WS_YR && WS_YR + (size_t)MROWS * WSSM * 4 <= WS_YPRE &&
              WS_YPRE + (size_t)MROWS * WSSM * 2 <= WS_END, "d_ws map");
constexpr int CW_QUEUE = 64, CW_BAR = 4096, CW_FLAG = 16384;
constexpr int P0_SIL_OFF = 69632, P0_RED_OFF = 118784, P0_Q_OFF = 131072;
constexpr int SSM_URING_OFF = 133120;
constexpr int LDSCTL_OFF = 143360, MISC_OFF = LDSCTL_OFF + 320;
constexpr int LDS_BYTES = 147456;
namespace pg8 {
#define PG8_LAS __attribute__((address_space(3)))
typedef unsigned short bf16_t;
typedef short bf16x8 __attribute__((ext_vector_type(8)));
typedef float f32x4 __attribute__((ext_vector_type(4)));
typedef unsigned u32x4 __attribute__((ext_vector_type(4)));
constexpr int BM = 256, BK = 64, HALF = 128, HTB = HALF * BK * 2  , STAGE_BYTES = 8 * HTB, NXCD = 8, WGM = 8;

__host__ __device__ __forceinline__ int lds_byte(int r, int c) { const int st = (r >> 4) * 2 + (c >> 5), rr = r & 15, cc = c & 31, ob = rr * 64 + cc * 2; return st * 1024 + (ob ^ (((ob >> 9) & 1) << 5)); }
__host__ __device__ __forceinline__ void stage_rc(int b, int& R, int& C) { const int st = b / 1024, sb = b % 1024, swz = sb ^ (((sb >> 9) & 1) << 5); R = (st >> 1) * 16 + swz / 64; C = (st & 1) * 32 + (swz % 64) / 2; }
__host__ __device__ __forceinline__ int perm32(int rho) { const int n = rho >> 4, i = rho & 15; return 8 * (i >> 2) + 4 * n + (i & 3); }

struct Unit { int pm, pn, k0, nt; };
struct Gemm { const bf16_t* A; const bf16_t* Bt; int M, N, K; };

struct StaticOrder {
    static constexpr bool HANDOFF = false;
    int nM, nN, nwg, G, c;
    __host__ __device__ void init(int M, int N, int G_, int c_) { nM = M / BM; nN = N / BM; nwg = nM * nN; G = G_; c = c_; }
    __host__ __device__ bool next(int i, Unit& u) const {
        const long L = (long)i * G + c; if (L >= nwg) return false;
        int wgid = (int)L; { const int q = nwg / NXCD, r = nwg % NXCD, xcd = wgid % NXCD, off = wgid / NXCD; wgid = (xcd < r ? xcd * (q + 1) : r * (q + 1) + (xcd - r) * q) + off; }
        const int nig = WGM * nN, gid = wgid / nig, fm = gid * WGM, gsz = (nM - fm) < WGM ? (nM - fm) : WGM;
        u.pm = fm + ((wgid % nig) % gsz); u.pn = (wgid % nig) / gsz; u.k0 = 0; u.nt = 0; return true;
    }
    __device__ __forceinline__ void a_ready(const Unit&) const {}
    __device__ __forceinline__ void done(const Unit&) const {}
};

__device__ __forceinline__ unsigned cvt_pk_bf16(float lo, float hi) { unsigned r; asm volatile("v_cvt_pk_bf16_f32 %0, %1, %2" : "=v"(r) : "v"(lo), "v"(hi)); return r; }
typedef float f32x2 __attribute__((ext_vector_type(2)));

struct SplitOrder {
    static constexpr bool HANDOFF = false;
    StaticOrder lat; int nlat_units, nN, nsplit_units, ks_tiles, G, c;
    __host__ __device__ void init(int Mlat, int Mctx, int N, int K, int KS, int G_, int c_) { lat.init(Mlat, N, G_, c_); nlat_units = (Mlat / BM) * (N / BM); nN = N / BM; nsplit_units = (Mctx / BM) * nN * KS; ks_tiles = K / BK / KS; G = G_; c = c_; ksn = KS; mlat_tiles = Mlat / BM; }
    int ksn, mlat_tiles;
    __host__ __device__ bool next(int i, Unit& u) const {
        const long L = (long)i * G + c;
        if (L < nlat_units) return lat.next(i, u);
        const int s = (int)(L - nlat_units); if (s >= nsplit_units) return false;
        const int per_pm = nN * ksn, rem = s % per_pm; u.pm = mlat_tiles + s / per_pm; u.pn = rem / ksn; const int ks = rem % ksn; u.k0 = ks * ks_tiles * BK; u.nt = ks_tiles; return true;
    }
    __device__ __forceinline__ void a_ready(const Unit&) const {}
    __device__ __forceinline__ void done(const Unit&) const {}
};

struct TwoPartOrder {
    static constexpr bool HANDOFF = false;
    StaticOrder lat; int nlat_units, nN, nctx_units, mlat_tiles, G, c, nwg;
    __host__ __device__ void init(int Mlat, int Mctx, int N, int G_, int c_) { lat.init(Mlat, N, G_, c_); nlat_units = (Mlat / BM) * (N / BM); nN = N / BM; nctx_units = (Mctx / BM) * nN; mlat_tiles = Mlat / BM; G = G_; c = c_; nwg = nlat_units + nctx_units; }
    __host__ __device__ bool next(int i, Unit& u) const {
        const long L = (long)i * G + c;
        if (L < nlat_units) return lat.next(i, u);
        const int s = (int)(L - nlat_units); if (s >= nctx_units) return false;
        u.pm = mlat_tiles + s / nN; u.pn = s % nN; u.k0 = 0; u.nt = 0; return true;
    }
    __device__ __forceinline__ void a_ready(const Unit&) const {}
    __device__ __forceinline__ void done(const Unit&) const {}
};

template <int KS, int PER> struct HandoffOrder {
    static constexpr bool HANDOFF = true;
    static constexpr int ks = KS, per = PER;
    StaticOrder lat; int nlat_units, nN, nctx_units, mlat_tiles, G, c, ktiles, flag_word; float* slab;
    __host__ __device__ void init(int Mlat, int Mctx, int N, int K, int G_, int c_, float* slab_, int flag_word_) { lat.init(Mlat, N, G_, c_); nlat_units = (Mlat / BM) * (N / BM); nN = N / BM;
        nctx_units = (Mctx / BM) * nN; mlat_tiles = Mlat / BM; G = G_; c = c_; ktiles = K / BK; slab = slab_; flag_word = flag_word_; }
    __host__ __device__ bool next(int i, Unit& u) const {
        const long L = (long)i * G + c;
        if (L < nlat_units) return lat.next(i, u);
        const int s = (int)(L - nlat_units);
        if (nlat_units % G != 0 || nctx_units * KS > G) { if (s >= nctx_units) return false; u.pm = mlat_tiles + s / nN; u.pn = s % nN; u.k0 = 0; u.nt = 0; return true; }
        if (s >= nctx_units * KS) return false;
        const int sl = (s >= nctx_units ? 1 : 0) + (s >= 2 * nctx_units ? 1 : 0) + (s >= 3 * nctx_units ? 1 : 0), uid = s - sl * nctx_units;
        u.pm = mlat_tiles + uid / nN; u.pn = uid % nN; u.k0 = sl * PER * BK; u.nt = (sl == KS - 1) ? ktiles - (KS - 1) * PER : PER; return true;
    }
    __device__ __forceinline__ int slice_of(const Unit& u) const { return u.k0 / (PER * BK); }
    __device__ __forceinline__ int uid_of(const Unit& u) const { return (u.pm - mlat_tiles) * nN + u.pn; }
    __device__ __forceinline__ unsigned* flag_of(int uid) const { return (unsigned*)((char*)slab - WS_PART + WS_CTL) + flag_word + uid; }
    __device__ __forceinline__ void a_ready(const Unit&) const {}
    __device__ __forceinline__ void done(const Unit&) const {}
};
constexpr int NLAT_ROWS = 16384, DMODEL = 4096, MODW = 36864;
__device__ __forceinline__ int row_set(int pm) { return pm < 32 ? 0 : (pm < 64 ? 1 : 2); }
__device__ __forceinline__ float bf_lo(unsigned w) { return __uint_as_float(w << 16); }
__device__ __forceinline__ float bf_hi(unsigned w) { return __uint_as_float(w & 0xffff0000u); }
__device__ __forceinline__ float sigmoid_f(float a) { return __builtin_amdgcn_rcpf(1.0f + __builtin_amdgcn_exp2f(-1.4426950408889634f * a)); }

struct EpiSwiGLU {
    static constexpr bool PERM = true, AFTER_DRAIN = false;
    bf16_t* O; int ldc;
    __device__ __forceinline__ void operator()(const f32x4 (&acc)[2][2][4][2], const Unit& u, int wr, int wc, int fr, int fq) const {
        const int row0 = u.pm * BM + wr * 64 + fr, col0 = u.pn * HALF + wc * 32 + 8 * fq;
#pragma unroll
        for (int ai = 0; ai < 2; ++ai)
#pragma unroll
            for (int m = 0; m < 4; ++m) { bf16_t* rowp = O + (size_t)(row0 + ai * HALF + m * 16) * ldc + col0;
                float h[8];
#pragma unroll
                for (int n = 0; n < 2; ++n)
#pragma unroll
                    for (int x = 0; x < 4; ++x) { const float a = acc[ai][0][m][n][x], b = acc[ai][1][m][n][x]; h[n * 4 + x] = a * b * sigmoid_f(a); }
                u32x4 w; w.x = cvt_pk_bf16(h[0], h[1]); w.y = cvt_pk_bf16(h[2], h[3]); w.z = cvt_pk_bf16(h[4], h[5]); w.w = cvt_pk_bf16(h[6], h[7]);
                *(u32x4*)rowp = w; }
    }
};
typedef _Float16 f16_t;
typedef _Float16 f16x8 __attribute__((ext_vector_type(8)));
typedef float f32x8 __attribute__((ext_vector_type(8)));
struct EpiResid {
    static constexpr bool PERM = true, AFTER_DRAIN = false;
    const float* base_lat32; const float* base_ctx32;
    f16_t* X; const float* gate; float scale; float* part;
    __device__ __forceinline__ void operator()(const f32x4 (&acc)[2][2][4][2], const Unit& u, int wr, int wc, int fr, int fq) const {
        const int col0 = u.pn * BM + wc * 32 + 8 * fq;
        const unsigned loff = (unsigned)((wr * 64 + fr) * DMODEL + col0);
        if (u.nt != 0) {
            float* pb = part + ((size_t)(u.k0 / (u.nt * BK)) * (2 * BM) + (size_t)(u.pm - 64) * BM) * DMODEL;
#pragma unroll
            for (int ai = 0; ai < 2; ++ai)
#pragma unroll
                for (int m = 0; m < 4; ++m) { float* dst = pb + (loff + (unsigned)((ai * HALF + m * 16) * DMODEL));
#pragma unroll
                    for (int bj = 0; bj < 2; ++bj) { *(f32x4*)(dst + bj * HALF) = acc[ai][bj][m][0]; *(f32x4*)(dst + bj * HALF + 4) = acc[ai][bj][m][1]; }
                    asm volatile("" ::: "memory"); }
            return; }
        const float* g = gate + row_set(u.pm) * MODW + col0;
        f16_t* dbase = X + (size_t)u.pm * BM * DMODEL;
        f32x4 gv[2][2];
#pragma unroll
        for (int bj = 0; bj < 2; ++bj)
#pragma unroll
            for (int n = 0; n < 2; ++n) gv[bj][n] = *(const f32x4*)(g + bj * HALF + 4 * n) * scale;
        if (base_lat32 != nullptr) {
            const float* sbase = (u.pm < 64) ? base_lat32 + (size_t)u.pm * BM * DMODEL : base_ctx32 + (size_t)(u.pm - 64) * BM * DMODEL;
#pragma unroll
            for (int ai = 0; ai < 2; ++ai)
#pragma unroll
              for (int m = 0; m < 4; ++m) { const unsigned o1 = loff + (unsigned)((ai * HALF + m * 16) * DMODEL);
                f32x4 bv[2][2];
#pragma unroll
                for (int bj = 0; bj < 2; ++bj)
#pragma unroll
                    for (int n = 0; n < 2; ++n) bv[bj][n] = *(const f32x4*)(sbase + o1 + bj * HALF + 4 * n);
#pragma unroll
                for (int bj = 0; bj < 2; ++bj) { const f32x4 r0 = bv[bj][0] + gv[bj][0] * acc[ai][bj][m][0], r1 = bv[bj][1] + gv[bj][1] * acc[ai][bj][m][1];
                    const f32x8 r = {r0[0], r0[1], r0[2], r0[3], r1[0], r1[1], r1[2], r1[3]}; *(f16x8*)(dbase + o1 + bj * HALF) = __builtin_convertvector(r, f16x8); }
                asm volatile("" ::: "memory"); }
        } else {
#pragma unroll
            for (int ai = 0; ai < 2; ++ai) {
                f16x8 bv[4][2];
#pragma unroll
                for (int m = 0; m < 4; ++m)
#pragma unroll
                    for (int bj = 0; bj < 2; ++bj) bv[m][bj] = *(const f16x8*)(dbase + (loff + (unsigned)((ai * HALF + m * 16) * DMODEL)) + bj * HALF);
#pragma unroll
                for (int m = 0; m < 4; ++m)
#pragma unroll
                    for (int bj = 0; bj < 2; ++bj) { const f32x8 b = __builtin_convertvector(bv[m][bj], f32x8);
                        const f32x4 a0 = acc[ai][bj][m][0], a1 = acc[ai][bj][m][1], g0 = gv[bj][0], g1 = gv[bj][1];
                        const f32x8 r = {b[0] + g0[0] * a0[0], b[1] + g0[1] * a0[1], b[2] + g0[2] * a0[2], b[3] + g0[3] * a0[3], b[4] + g1[0] * a1[0], b[5] + g1[1] * a1[1], b[6] + g1[2] * a1[2], b[7] + g1[3] * a1[3]};
                        *(f16x8*)(dbase + (loff + (unsigned)((ai * HALF + m * 16) * DMODEL)) + bj * HALF) = __builtin_convertvector(r, f16x8); }
                asm volatile("" ::: "memory"); }
        }
    }
};
struct EpiRope {
    static constexpr bool PERM = true, AFTER_DRAIN = false;
    bf16_t* O; int ldc; const float* tab;
    __device__ __forceinline__ void operator()(const f32x4 (&acc)[2][2][4][2], const Unit& u, int wr, int wc, int fr, int fq) const {
        const bool rope = (u.pn >= 12 && u.pn < 28 && u.pm < 64);
        const float qs = (u.pn >= 12 && u.pn < 20) ? 0.18033688011112042f : 1.0f;
        const int col0 = u.pn * BM + wc * 32 + 8 * fq;
        const bool first = fq < 2;
#pragma unroll
        for (int ai = 0; ai < 2; ++ai)
#pragma unroll
            for (int m = 0; m < 4; ++m) { const int row = u.pm * BM + ai * HALF + wr * 64 + m * 16 + fr; bf16_t* rowp = O + (size_t)row * ldc + col0;
                if (rope) { const int t = row & 8191, pos = (wc & 1) ? (t & 63) : (t >> 6); const float* tp = tab + pos * 32 + 8 * (fq & 1);
                    const f32x4 cs0 = *(const f32x4*)tp, cs1 = *(const f32x4*)(tp + 4), sn0 = *(const f32x4*)(tp + 16), sn1 = *(const f32x4*)(tp + 20);
#pragma unroll
                    for (int bj = 0; bj < 2; ++bj) { float o[8];
#pragma unroll
                        for (int n = 0; n < 2; ++n)
#pragma unroll
                            for (int x = 0; x < 4; ++x) { const float v = acc[ai][bj][m][n][x];
                                const auto rr = __builtin_amdgcn_permlane32_swap(__float_as_uint(v), __float_as_uint(v), false, false);
                                const float p = __uint_as_float(first ? rr[1] : rr[0]);
                                const float c = n ? cs1[x] : cs0[x], s = n ? sn1[x] : sn0[x];
                                o[4 * n + x] = (first ? v * c - p * s : v * c + p * s) * qs; }
                        u32x4 w; w.x = cvt_pk_bf16(o[0], o[1]); w.y = cvt_pk_bf16(o[2], o[3]); w.z = cvt_pk_bf16(o[4], o[5]); w.w = cvt_pk_bf16(o[6], o[7]);
                        *(u32x4*)(rowp + bj * HALF) = w; }
                } else {
#pragma unroll
                    for (int bj = 0; bj < 2; ++bj) { const f32x4 v0 = acc[ai][bj][m][0] * qs, v1 = acc[ai][bj][m][1] * qs;
                        u32x4 w; w.x = cvt_pk_bf16(v0[0], v0[1]); w.y = cvt_pk_bf16(v0[2], v0[3]); w.z = cvt_pk_bf16(v1[0], v1[1]); w.w = cvt_pk_bf16(v1[2], v1[3]);
                        *(u32x4*)(rowp + bj * HALF) = w; } }
            }
    }
};
struct EpiGlu {
    static constexpr bool PERM = true, AFTER_DRAIN = false;
    const bf16_t* Y; int ldy; bf16_t* O; int ldc; int ocol0;
    __device__ __forceinline__ void operator()(const f32x4 (&acc)[2][2][4][2], const Unit& u, int wr, int wc, int fr, int fq) const {
        const int row0 = u.pm * BM + wr * 64 + fr, col0 = u.pn * BM + wc * 32 + 8 * fq;
#pragma unroll
        for (int ai = 0; ai < 2; ++ai)
#pragma unroll
            for (int m = 0; m < 4; ++m) { const size_t row = (size_t)(row0 + ai * HALF + m * 16);
#pragma unroll
                for (int bj = 0; bj < 2; ++bj) { const int c = col0 + bj * HALF; const u32x4 yv = *(const u32x4*)(Y + row * ldy + c);
                    const f32x4 v0 = acc[ai][bj][m][0], v1 = acc[ai][bj][m][1];
                    u32x4 w; w.x = cvt_pk_bf16(bf_lo(yv.x) * sigmoid_f(v0[0]), bf_hi(yv.x) * sigmoid_f(v0[1])); w.y = cvt_pk_bf16(bf_lo(yv.y) * sigmoid_f(v0[2]), bf_hi(yv.y) * sigmoid_f(v0[3]));
                    w.z = cvt_pk_bf16(bf_lo(yv.z) * sigmoid_f(v1[0]), bf_hi(yv.z) * sigmoid_f(v1[1])); w.w = cvt_pk_bf16(bf_lo(yv.w) * sigmoid_f(v1[2]), bf_hi(yv.w) * sigmoid_f(v1[3]));
                    *(u32x4*)(O + row * ldc + ocol0 + c) = w; } }
    }
};

struct EpiNull {
    static constexpr bool PERM = false, AFTER_DRAIN = false;
    float* O;
    __device__ __forceinline__ void operator()(const f32x4 (&acc)[2][2][4][2], const Unit& u, int wr, int wc, int fr, int fq) const {
        f32x4 s = {0.f, 0.f, 0.f, 0.f};
#pragma unroll
        for (int ai = 0; ai < 2; ++ai)
#pragma unroll
            for (int bj = 0; bj < 2; ++bj)
#pragma unroll
                for (int m = 0; m < 4; ++m)
#pragma unroll
                    for (int n = 0; n < 2; ++n) s += acc[ai][bj][m][n];
        *(f32x4*)(O + ((size_t)(u.pm * 16 + u.pn) * 512 + (wr * 4 + wc) * 64 + fq * 16 + fr) * 4) = s;
    }
};
template <class Epi, class Sched, bool ALIGN_EPI = false, bool SP2 = false>
__device__ __forceinline__ void gemm_phase(PG8_LAS unsigned char* lds, const Gemm g, const Sched& S, const Epi& E) {
    int tid_ = threadIdx.x; asm volatile("" : "+v"(tid_));
    const int tid = tid_, wid = __builtin_amdgcn_readfirstlane(tid >> 6), lane = tid & 63, wr = wid >> 2, wc = wid & 3, fr = lane & 15, fq = lane >> 4;
    const int K = g.K, nt = K / BK;
    unsigned voffA[2], voffB[2];
#pragma unroll
    for (int i = 0; i < 2; ++i) { int R, C; stage_rc(tid * 16 + i * 8192, R, C); const int Rb = Epi::PERM ? ((R & ~31) + perm32(R & 31)) : R;
        voffA[i] = (unsigned)(R * K + C) * 2u; voffB[i] = (unsigned)(Rb * K + C) * 2u; }
    const size_t kstep = (size_t)(BK * 2);
    const size_t hstep = (size_t)HALF * K * 2;
    const size_t tstep = 2 * hstep;
    const unsigned ldsu = (unsigned)(uintptr_t)lds;
    const unsigned ldsw = (unsigned)wid * 1024u;
    const int aoff = lds_byte(wr * 64 + fr, fq * 8), boff = lds_byte(wc * 32 + fr, fq * 8);
#define PG8_SA(b, h) (((b) * 2 + (h)) * HTB)
#define PG8_SB(b, h) ((4 + (b) * 2 + (h)) * HTB)
#define PG8_STAGE(bufoff, gbase, voff) do {     \
        asm volatile("s_mov_b32 m0, %3\n\ts_nop 0\n\tglobal_load_lds_dwordx4 %0, %2\n\ts_mov_b32 m0, %4\n\ts_nop 0\n\tglobal_load_lds_dwordx4 %1, %2" \
            :: "v"((voff)[0]), "v"((voff)[1]), "s"((const char*)(gbase)), "s"(ldsu + (unsigned)(bufoff) + ldsw), "s"(ldsu + (unsigned)(bufoff) + ldsw + 8192u) : "memory"); } while (0)
#define PG8_LDA(dst, b, h) do { _Pragma("unroll") for (int m = 0; m < 4; ++m) _Pragma("unroll") for (int k = 0; k < 2; ++k) dst[m][k] = *(const PG8_LAS bf16x8*)(lds + PG8_SA(b, h) + aoff + m * 2048 + k * 1024); } while (0)
#define PG8_LDB(dst, b, h) do { _Pragma("unroll") for (int n = 0; n < 2; ++n) _Pragma("unroll") for (int k = 0; k < 2; ++k) dst[n][k] = *(const PG8_LAS bf16x8*)(lds + PG8_SB(b, h) + boff + n * 2048 + k * 1024); } while (0)
#define PG8_MMA(ai, bj, At, Bt) do { _Pragma("unroll") for (int m = 0; m < 4; ++m) _Pragma("unroll") for (int n = 0; n < 2; ++n) _Pragma("unroll") for (int k = 0; k < 2; ++k) \
        acc[ai][bj][m][n] = __builtin_amdgcn_mfma_f32_16x16x32_bf16(Bt[n][k], At[m][k], acc[ai][bj][m][n], 0, 0, 0); } while (0)
#define PG8_MMAP(ai, bj, At, Bt) do { __builtin_amdgcn_s_setprio(1); PG8_MMA(ai, bj, At, Bt); __builtin_amdgcn_s_setprio(0); } while (0)
#define PG8_WAIT_V(n) asm volatile("s_waitcnt vmcnt(" #n ")" ::: "memory")
#define PG8_WAIT_L(n) asm volatile("s_waitcnt lgkmcnt(" #n ")" ::: "memory")
#define PG8_WAIT_L0 do { __builtin_amdgcn_s_waitcnt(0xC07F); asm volatile("" ::: "memory"); } while (0)
#define PG8_BAR __builtin_amdgcn_s_barrier()
#define PG8_SCHED __builtin_amdgcn_sched_barrier(0)
    Unit cur, nxt; int ui = 0;
    if (!S.next(0, cur)) return;
    f32x4 acc[2][2][4][2];
#pragma unroll
    for (int a = 0; a < 2; ++a)
#pragma unroll
        for (int b = 0; b < 2; ++b)
#pragma unroll
            for (int m = 0; m < 4; ++m)
#pragma unroll
                for (int n = 0; n < 2; ++n) acc[a][b][m][n] = (f32x4){0.f, 0.f, 0.f, 0.f};
    bf16x8 At[4][2], B0[2][2], B1[2][2];
    const char* cA = (const char*)g.A + (size_t)cur.pm * tstep + (size_t)cur.k0 * 2; const char* cB = (const char*)g.Bt + (size_t)cur.pn * tstep + (size_t)cur.k0 * 2;
    S.a_ready(cur);
    if constexpr (SP2) {
        PG8_STAGE(PG8_SB(0, 0), cB, voffB); PG8_STAGE(PG8_SB(0, 1), cB + hstep, voffB); PG8_STAGE(PG8_SA(0, 0), cA, voffA); PG8_STAGE(PG8_SA(0, 1), cA + hstep, voffA);
        if (wr == 1) PG8_BAR;
        PG8_WAIT_V(2); PG8_BAR;
        PG8_STAGE(PG8_SB(1, 0), cB + kstep, voffB); PG8_STAGE(PG8_SA(1, 0), cA + kstep, voffA); PG8_STAGE(PG8_SB(1, 1), cB + hstep + kstep, voffB);
        PG8_WAIT_V(6); PG8_BAR;
    } else {
        PG8_STAGE(PG8_SB(0, 0), cB, voffB); PG8_STAGE(PG8_SA(0, 0), cA, voffA); PG8_STAGE(PG8_SB(0, 1), cB + hstep, voffB); PG8_STAGE(PG8_SA(0, 1), cA + hstep, voffA);
        if (wr == 1) PG8_BAR;
        PG8_WAIT_V(4); PG8_BAR;
        PG8_STAGE(PG8_SB(1, 0), cB + kstep, voffB); PG8_STAGE(PG8_SA(1, 0), cA + kstep, voffA); PG8_STAGE(PG8_SB(1, 1), cB + hstep + kstep, voffB);
        PG8_WAIT_V(6); PG8_BAR;
    }
    for (;;) {
        const bool has_next = S.next(ui + 1, nxt);
        const char* nA = has_next ? (const char*)g.A + (size_t)nxt.pm * tstep + (size_t)nxt.k0 * 2 : cA; const char* nB = has_next ? (const char*)g.Bt + (size_t)nxt.pn * tstep + (size_t)nxt.k0 * 2 : cB;
        const int cnt = cur.nt ? cur.nt : nt;
        for (int t = 0; t < cnt; t += 2) {
            const bool last = (t == cnt - 2);
            const char* a1 = cA + (size_t)(t + 1) * kstep;
            const char* a2 = last ? nA : cA + (size_t)(t + 2) * kstep; const char* b2 = last ? nB : cB + (size_t)(t + 2) * kstep;
            const char* a3 = a2 + kstep; const char* b3 = b2 + kstep;
            if (last && has_next) S.a_ready(nxt);
            if constexpr (SP2) {
            PG8_LDB(B0, 0, 0); PG8_LDB(B1, 0, 1); PG8_SCHED; PG8_LDA(At, 0, 0); PG8_STAGE(PG8_SA(1, 1), a1 + hstep, voffA);
            PG8_WAIT_V(8); PG8_WAIT_L0; __builtin_amdgcn_s_setprio(1); PG8_BAR; PG8_MMA(0, 0, At, B0); PG8_MMA(0, 1, At, B1); __builtin_amdgcn_s_setprio(0); PG8_BAR; PG8_SCHED;
            PG8_LDA(At, 0, 1); PG8_STAGE(PG8_SB(0, 0), b2, voffB); PG8_STAGE(PG8_SB(0, 1), b2 + hstep, voffB); PG8_STAGE(PG8_SA(0, 0), a2, voffA);
            PG8_WAIT_V(8); PG8_WAIT_L0; __builtin_amdgcn_s_setprio(1); PG8_BAR; PG8_MMA(1, 0, At, B0); PG8_MMA(1, 1, At, B1); __builtin_amdgcn_s_setprio(0); PG8_BAR; PG8_SCHED;
            PG8_LDB(B0, 1, 0); PG8_LDB(B1, 1, 1); PG8_SCHED; PG8_LDA(At, 1, 0); PG8_STAGE(PG8_SA(0, 1), a2 + hstep, voffA);
            PG8_WAIT_V(8); PG8_WAIT_L0; __builtin_amdgcn_s_setprio(1); PG8_BAR; PG8_MMA(0, 0, At, B0); PG8_MMA(0, 1, At, B1); __builtin_amdgcn_s_setprio(0); PG8_BAR; PG8_SCHED;
            PG8_LDA(At, 1, 1); PG8_STAGE(PG8_SB(1, 0), b3, voffB); PG8_STAGE(PG8_SB(1, 1), b3 + hstep, voffB); PG8_STAGE(PG8_SA(1, 0), a3, voffA);
            PG8_WAIT_V(8); PG8_WAIT_L0; __builtin_amdgcn_s_setprio(1); PG8_BAR; PG8_MMA(1, 0, At, B0); PG8_MMA(1, 1, At, B1); __builtin_amdgcn_s_setprio(0); PG8_BAR; PG8_SCHED;
            } else {
            PG8_LDB(B0, 0, 0); PG8_SCHED; PG8_LDA(At, 0, 0); PG8_STAGE(PG8_SA(1, 1), a1 + hstep, voffA);
            PG8_WAIT_L(8); PG8_BAR; PG8_WAIT_L(0); PG8_MMAP(0, 0, At, B0); PG8_BAR; PG8_SCHED;
            PG8_LDB(B1, 0, 1); PG8_STAGE(PG8_SB(0, 0), b2, voffB);
            PG8_BAR; PG8_WAIT_L(0); PG8_MMAP(0, 1, At, B1); PG8_BAR;
            PG8_LDA(At, 0, 1); PG8_STAGE(PG8_SA(0, 0), a2, voffA);
            PG8_BAR; PG8_WAIT_L(0); PG8_MMAP(1, 0, At, B0); PG8_BAR; PG8_SCHED;
            PG8_STAGE(PG8_SB(0, 1), b2 + hstep, voffB);
            PG8_WAIT_V(6); PG8_BAR; PG8_MMAP(1, 1, At, B1); PG8_BAR;
            PG8_LDB(B0, 1, 0); PG8_SCHED; PG8_LDA(At, 1, 0); PG8_STAGE(PG8_SA(0, 1), a2 + hstep, voffA);
            PG8_WAIT_L(8); PG8_BAR; PG8_WAIT_L(0); PG8_MMAP(0, 0, At, B0); PG8_BAR; PG8_SCHED;
            PG8_LDB(B1, 1, 1); PG8_STAGE(PG8_SB(1, 0), b3, voffB);
            PG8_BAR; PG8_WAIT_L(0); PG8_MMAP(0, 1, At, B1); PG8_BAR;
            PG8_LDA(At, 1, 1); PG8_STAGE(PG8_SA(1, 0), a3, voffA);
            PG8_BAR; PG8_WAIT_L(0); PG8_MMAP(1, 0, At, B0); PG8_BAR; PG8_SCHED;
            PG8_STAGE(PG8_SB(1, 1), b3 + hstep, voffB);
            PG8_WAIT_V(6); PG8_BAR; PG8_MMAP(1, 1, At, B1); PG8_BAR;
            }
        }
        if constexpr (ALIGN_EPI) { if (wr == 0) PG8_BAR; }
        if constexpr (Sched::HANDOFF) {
            if (cur.nt != 0) {
                typedef __attribute__((address_space(1))) unsigned g_u32; typedef __attribute__((address_space(1))) f32x4 g_f32x4;
                const int sl = S.slice_of(cur), uid = S.uid_of(cur);
                const int tid2 = wid * 64 + fq * 16 + fr;
                const unsigned voff_ = (unsigned)tid2 * 16u;
                const char* ub = (const char*)(S.slab + (size_t)uid * (size_t)(S.ks - 1) * 65536u);
                g_u32* fl = (g_u32*)S.flag_of(uid);
                if (sl < S.ks - 1) {
                    const char* pb_ = ub + (size_t)sl * 262144u;
#pragma unroll
                    for (int a = 0; a < 2; ++a)
#pragma unroll
                        for (int b = 0; b < 2; ++b)
#pragma unroll
                            for (int m = 0; m < 4; ++m)
#pragma unroll
                                for (int n = 0; n < 2; ++n)
#ifndef HO_NOSTORE
 asm volatile("global_store_dwordx4 %0, %1, %2 sc1" :: "v"(voff_), "v"(acc[a][b][m][n]), "s"(pb_ + (((a * 2 + b) * 4 + m) * 2 + n) * 8192) : "memory");
#else
 ;
#endif
                    asm volatile("s_waitcnt vmcnt(0)" ::: "memory");
                    __syncthreads();
                    if (tid2 == 0) __hip_atomic_fetch_add(fl, 1u, __ATOMIC_RELAXED, __HIP_MEMORY_SCOPE_AGENT);
                    break;
                } else {
                    if (wid == 0) {
                        if ((fq | fr) == 0) { unsigned spins = 0; while (__hip_atomic_load(fl, __ATOMIC_RELAXED, __HIP_MEMORY_SCOPE_AGENT) < (unsigned)(S.ks - 1) && ++spins < (1u << 16)) __builtin_amdgcn_s_sleep(4); }
                        __builtin_amdgcn_fence(__ATOMIC_ACQUIRE, "agent"); }
                    asm volatile("s_waitcnt vmcnt(0)" ::: "memory");
                    __syncthreads();
                    for (int s_ = 0; s_ < S.ks - 1; ++s_) { const char* qb_ = ub + (size_t)s_ * 262144u;
#pragma unroll
                        for (int a = 0; a < 2; ++a) { f32x4 t_[16];
#pragma unroll
                            for (int i = 0; i < 16; ++i) asm volatile("global_load_dwordx4 %0, %1, %2" : "=v"(t_[i]) : "v"(voff_), "s"(qb_ + (a * 16 + i) * 8192) : "memory");
                            asm volatile("s_waitcnt vmcnt(0)" : "+v"(t_[0]), "+v"(t_[1]), "+v"(t_[2]), "+v"(t_[3]), "+v"(t_[4]), "+v"(t_[5]), "+v"(t_[6]), "+v"(t_[7]),
                                         "+v"(t_[8]), "+v"(t_[9]), "+v"(t_[10]), "+v"(t_[11]), "+v"(t_[12]), "+v"(t_[13]), "+v"(t_[14]), "+v"(t_[15]) :: "memory");
#pragma unroll
                            for (int i = 0; i < 16; ++i) acc[a][i >> 3][(i >> 1) & 3][i & 1] += t_[i]; }
                    }
                }
            }
        }
        if constexpr (!Epi::AFTER_DRAIN) { E(acc, cur, wr, wc, fr, fq); S.done(cur); }
        if (!has_next) break;
#pragma unroll
        for (int a = 0; a < 2; ++a)
#pragma unroll
            for (int b = 0; b < 2; ++b)
#pragma unroll
                for (int m = 0; m < 4; ++m)
#pragma unroll
                    for (int n = 0; n < 2; ++n) acc[a][b][m][n] = (f32x4){0.f, 0.f, 0.f, 0.f};
        cur = nxt; cA = nA; cB = nB; ++ui;
        if constexpr (ALIGN_EPI) { if (wr == 1) PG8_BAR; }
    }
    PG8_WAIT_V(0);
    if constexpr (!ALIGN_EPI) { if (wr == 0) PG8_BAR; }
    PG8_BAR;
    if constexpr (Epi::AFTER_DRAIN) { E.fused(acc, cur, wr, wc, fr, fq, lds, wid, lane); S.done(cur); }
#undef PG8_SA
#undef PG8_SB
#undef PG8_STAGE
#undef PG8_LDA
#undef PG8_LDB
#undef PG8_MMA
#undef PG8_MMAP
#undef PG8_WAIT_L0
#undef PG8_WAIT_V
#undef PG8_WAIT_L
#undef PG8_BAR
#undef PG8_SCHED
}
}
namespace att {
using bf16x8 = __attribute__((ext_vector_type(8))) short;
using s16x4  = __attribute__((ext_vector_type(4))) short;
using f32x16 = __attribute__((ext_vector_type(16))) float;
using u32x4  = __attribute__((ext_vector_type(4))) unsigned;
typedef unsigned short bf16_t;
constexpr int NW = 8, QBLK = 32, KVBLK = 64, LDP = 10240, LDY = 4096;
constexpr int OFF_Q = 3072, OFF_K = 5120, OFF_V = 7168, YC_ATT = 1024;
constexpr float SCALE = 0.125f, THR = 8.f;
constexpr int SHM_V = KVBLK * 128 * 2, SHM_K = KVBLK * 128 * 2, SHM_ATTN = 2 * SHM_V + 2 * SHM_K + NW * 64 * 4;
#define KSWZ(row, colB) ((row) * 256 + ((colB) ^ (((row) & 7) << 4)))
#define SBAR() __builtin_amdgcn_sched_barrier(0)
__device__ __forceinline__ int crow(int r, int hi) { return (r & 3) + 8 * (r >> 2) + 4 * hi; }
__device__ __forceinline__ unsigned cvtpk(float lo, float hi) { unsigned r; asm volatile("v_cvt_pk_bf16_f32 %0, %1, %2" : "=v"(r) : "v"(lo), "v"(hi)); return r; }
__device__ __forceinline__ bf16x8 ld8(const bf16_t* p) { return *reinterpret_cast<const bf16x8*>(p); }

__device__ __forceinline__ void partialSM(f32x16& p0, f32x16& p1, float& m_reg, float& mn, float& alpha) {
  constexpr float C = SCALE * 1.4426950408889634f;
  float pmax = p0[0];
#pragma unroll
  for (int r = 1; r < 16; ++r) pmax = fmaxf(pmax, p0[r]);
#pragma unroll
  for (int r = 0; r < 16; ++r) pmax = fmaxf(pmax, p1[r]);
  { auto rr = __builtin_amdgcn_permlane32_swap(__float_as_uint(pmax), __float_as_uint(pmax), false, false);
    pmax = fmaxf(__uint_as_float(rr[0]), __uint_as_float(rr[1])); }
  if (__builtin_expect(__all(pmax - m_reg <= THR / SCALE), 1)) { mn = m_reg; alpha = 1.f; }
  else { mn = fmaxf(m_reg, pmax); alpha = __builtin_amdgcn_exp2f((m_reg - mn) * C); m_reg = mn; }
  float mnC = -mn * C;
#pragma unroll
  for (int r = 0; r < 16; ++r) p0[r] = fmaf(p0[r], C, mnC);
#pragma unroll
  for (int r = 0; r < 16; ++r) p1[r] = fmaf(p1[r], C, mnC);
#pragma unroll
  for (int r = 0; r < 16; ++r) p0[r] = __builtin_amdgcn_exp2f(p0[r]);
}
__device__ __forceinline__ void finishSM(f32x16& p0, f32x16& p1, float alpha, float& l_reg, bf16x8& pa0, bf16x8& pa1, bf16x8& pa2, bf16x8& pa3) {
#pragma unroll
  for (int r = 0; r < 16; ++r) p1[r] = __builtin_amdgcn_exp2f(p1[r]);
  float ps = 0;
#pragma unroll
  for (int r = 0; r < 16; ++r) ps += p0[r];
#pragma unroll
  for (int r = 0; r < 16; ++r) ps += p1[r];
  { auto rr = __builtin_amdgcn_permlane32_swap(__float_as_uint(ps), __float_as_uint(ps), false, false);
    ps = __uint_as_float(rr[0]) + __uint_as_float(rr[1]); }
  l_reg = l_reg * alpha + ps;
#define PK4(P, BASE, OUT) do { u32x4 w = {cvtpk(P[BASE + 0], P[BASE + 1]), cvtpk(P[BASE + 2], P[BASE + 3]), cvtpk(P[BASE + 4], P[BASE + 5]), cvtpk(P[BASE + 6], P[BASE + 7])}; OUT = *reinterpret_cast<bf16x8*>(&w); } while (0)
  PK4(p0, 0, pa0); PK4(p0, 8, pa1); PK4(p1, 0, pa2); PK4(p1, 8, pa3);
#undef PK4
}
__device__ __forceinline__ void qkt(f32x16& p0, f32x16& p1, const char* Ks, const bf16x8* qr, int r32, int hi, int colB0) {
  p0 = f32x16{}; p1 = f32x16{};
#pragma unroll
  for (int d0 = 0; d0 < 4; ++d0) { int cb = colB0 + (d0 * 16 + hi * 8) * 2;
    bf16x8 b0 = *reinterpret_cast<const bf16x8*>(Ks + KSWZ(r32, cb));
    bf16x8 b1 = *reinterpret_cast<const bf16x8*>(Ks + KSWZ(32 + r32, cb));
    p0 = __builtin_amdgcn_mfma_f32_32x32x16_bf16(b0, qr[d0], p0, 0, 0, 0);
    p1 = __builtin_amdgcn_mfma_f32_32x32x16_bf16(b1, qr[d0], p1, 0, 0, 0); }
}
__device__ __forceinline__ int v_st(int k, int c) { const int kk = (k & ~0xC) | ((k & 4) << 1) | ((k & 8) >> 1); return ((kk >> 3) * 4 + (c >> 5)) * 512 + ((kk & 7) * 32 + (c & 31)) * 2; }
__device__ __forceinline__ int v_rd_base(int lane) { return ((lane & 3) << 3) | (((lane >> 2) & 3) << 6) | (((lane >> 4) & 1) << 5) | (((lane >> 5) & 1) << 11); }
constexpr int v_rd_off(int d0, int ks, int half) { return d0 * 512 + ks * 4096 + half * 256; }
template <int OFF> __device__ __forceinline__ s16x4 tr_read(int vb) {
  s16x4 r; asm volatile("ds_read_b64_tr_b16 %0, %1 offset:%2" : "=&v"(r) : "v"(vb), "i"(OFF) : "memory"); return r;
}
typedef short v4i16_t __attribute__((ext_vector_type(4)));
typedef __attribute__((address_space(3))) v4i16_t* lds_v4i16_p;
__device__ __forceinline__ s16x4 vtr(int addr) { return __builtin_bit_cast(s16x4, __builtin_amdgcn_ds_read_tr16_b64_v4i16((lds_v4i16_p)(uintptr_t)(unsigned)addr)); }
__device__ __forceinline__ void pv_all(f32x16* o, int vb, bf16x8 pa0, bf16x8 pa1, bf16x8 pa2, bf16x8 pa3) {
#define PK(L, H) (bf16x8){L[0], L[1], L[2], L[3], H[0], H[1], H[2], H[3]}
#define PVKS(KS, PA) do { _Pragma("unroll") for (int d0 = 0; d0 < 4; ++d0) { const s16x4 l_ = vtr(vb + v_rd_off(d0, KS, 0)), h_ = vtr(vb + v_rd_off(d0, KS, 1)); \
    o[d0] = __builtin_amdgcn_mfma_f32_32x32x16_bf16(PA, PK(l_, h_), o[d0], 0, 0, 0); } } while (0)
  PVKS(0, pa0); PVKS(1, pa1); PVKS(2, pa2); PVKS(3, pa3);
#undef PVKS
#undef PK
}
__device__ __forceinline__ void qkt_c(f32x16& p0, f32x16& p1, const char* Ks, const bf16x8* qr, int r32, int hi, int colB0, const f32x16& cin) {
#pragma unroll
  for (int d0 = 0; d0 < 4; ++d0) { int cb = colB0 + (d0 * 16 + hi * 8) * 2;
    bf16x8 b0 = *reinterpret_cast<const bf16x8*>(Ks + KSWZ(r32, cb));
    bf16x8 b1 = *reinterpret_cast<const bf16x8*>(Ks + KSWZ(32 + r32, cb));
    p0 = __builtin_amdgcn_mfma_f32_32x32x16_bf16(b0, qr[d0], d0 == 0 ? cin : p0, 0, 0, 0);
    p1 = __builtin_amdgcn_mfma_f32_32x32x16_bf16(b1, qr[d0], d0 == 0 ? cin : p1, 0, 0, 0); }
}

struct AttnArgs { const bf16_t* P; bf16_t* YC; const float* subg; float lam, oscale; };
#ifndef THRL_VALUE
#define THRL_VALUE 8.f
#endif
constexpr int KRING = 0, VRING = 4 * SHM_K, LDS_WS_OFF = VRING + 4 * SHM_V;
constexpr float THRL = THRL_VALUE;
__device__ __forceinline__ void glds16(const void* gsrc, unsigned lds_dst) { unsigned keep;
  asm volatile("s_mov_b32 %0, m0\n\ts_mov_b32 m0, %2\n\ts_nop 0\n\tglobal_load_lds_dwordx4 %1, off\n\ts_mov_b32 m0, %0" : "=&s"(keep) : "v"(gsrc), "s"(lds_dst) : "memory"); }
__device__ __forceinline__ void glds16s(const void* sbase, unsigned voff, unsigned lds_dst) { unsigned keep = 0;
  asm volatile("s_mov_b32 m0, %2\n\ts_nop 0\n\tglobal_load_lds_dwordx4 %0, %1" :: "v"(voff), "s"(sbase), "s"(lds_dst) : "memory"); (void)keep; }
#define BAR_L() asm volatile("s_waitcnt lgkmcnt(0)\n\ts_barrier" ::: "memory")
#define BAR_VL8() asm volatile("s_waitcnt vmcnt(8) lgkmcnt(0)\n\ts_barrier" ::: "memory")
__device__ __forceinline__ void attn_unit(const AttnArgs& A, int qrow0, int h, int krow_a, int nt_a, int krow_b, int NT, char* lds) {
  int tid_ = threadIdx.x; asm volatile("" : "+v"(tid_));
  const int tid = tid_, wid = __builtin_amdgcn_readfirstlane(tid >> 6), lane = tid & 63, r32 = lane & 31, hi = lane >> 5;
  const int js = wid >> 2, qw = wid & 3;
  const unsigned lds0 = (unsigned)(uintptr_t)lds;
  float* ws = (float*)(lds + LDS_WS_OFF) + wid * 64; float* li_l = ws; float* al_l = ws + 32;
  float m_reg = 0.f, l_reg = 0.f; f32x16 o[4] = {}; f32x16 negm = {}; bf16x8 qr[4];
  const bf16_t* Qw = A.P + (size_t)(qrow0 + qw * QBLK + r32) * LDP + OFF_Q + h * 128 + js * 64 + hi * 8;
  const bf16_t* Kh = A.P + OFF_K + h * 128; const bf16_t* Vh = A.P + OFF_V + h * 128;
  int koff[2], voff[2];
#pragma unroll
  for (int i = 0; i < 2; ++i) { const int c = wid * 2 + i;
    { const int row = 4 * c + (lane >> 4), p = lane & 15; koff[i] = (row * LDP + 8 * (p ^ (row & 7))) * 2; }
    { const int U = c * 64 + lane, S = U >> 5, kk = (S >> 2) * 8 + ((U & 31) >> 2), k = (kk & ~0xC) | ((kk & 4) << 1) | ((kk & 8) >> 1); voff[i] = (k * LDP + (S & 3) * 32 + (U & 3) * 8) * 2; } }
  const int vb0 = (int)lds0 + VRING + v_rd_base(lane);
  const int colB0 = js * 128;
#define TROW(t) ((t) < nt_a ? krow_a + (t) * KVBLK : krow_b + ((t) - nt_a) * KVBLK)
#define ISSUE1(tk, tv, PI) do { const int tk_ = (tk) < NT ? (tk) : NT - 1, tv_ = (tv) < 0 ? 0 : ((tv) < NT ? (tv) : NT - 1); \
    if ((PI) < 2) glds16s((const char*)Kh + (size_t)(TROW(tk_)) * (LDP * 2), (unsigned)koff[(PI) & 1], (unsigned)__builtin_amdgcn_readfirstlane(lds0 + KRING + ((tk) & 3) * SHM_K + wid * 2048 + ((PI) & 1) * 1024)); \
    else glds16s((const char*)Vh + (size_t)(TROW(tv_)) * (LDP * 2), (unsigned)voff[(PI) & 1], (unsigned)__builtin_amdgcn_readfirstlane(lds0 + VRING + ((tv) & 3) * SHM_V + wid * 2048 + ((PI) & 1) * 1024)); } while (0)
#define ISSUE(tk, tv) do { ISSUE1(tk, tv, 0); ISSUE1(tk, tv, 1); ISSUE1(tk, tv, 2); ISSUE1(tk, tv, 3); } while (0)
  bf16x8 pa0 = {}, pa1 = {}, pa2 = {}, pa3 = {};
  ISSUE(0, -1); ISSUE(1, 0); ISSUE(2, 1);
#pragma unroll
  for (int d0 = 0; d0 < 4; ++d0) qr[d0] = ld8(Qw + d0 * 16);
#pragma unroll
  for (int d0 = 0; d0 < 4; ++d0) asm volatile("" : "+v"(qr[d0]));
  asm volatile("s_waitcnt vmcnt(0)" ::: "memory");
  BAR_L();
  s16x4 va[8], vbq[8];
#pragma unroll
  for (int q = 0; q < 8; ++q) { va[q] = s16x4{}; vbq[q] = s16x4{}; }
  __builtin_amdgcn_s_setprio(1);
  for (int j = 0; j < NT; ++j) {
    f32x16 p0, p1;
    {
      const char* Ks = lds + KRING + (j & 3) * SHM_K; const int vb = vb0 + ((j - 1) & 3) * SHM_V;
      bf16x8 kf[8];
#pragma unroll
      for (int d0 = 0; d0 < 4; ++d0) { const int cb = colB0 + (d0 * 16 + hi * 8) * 2;
        kf[2 * d0] = *reinterpret_cast<const bf16x8*>(Ks + KSWZ(r32, cb)); kf[2 * d0 + 1] = *reinterpret_cast<const bf16x8*>(Ks + KSWZ(32 + r32, cb));
        if (d0 == 0) SBAR(); }
#define VLD(DST, KS) do { _Pragma("unroll") for (int d0 = 0; d0 < 4; ++d0) { DST[2 * d0] = vtr(vb + v_rd_off(d0, KS, 0)); DST[2 * d0 + 1] = vtr(vb + v_rd_off(d0, KS, 1)); } } while (0)
#define PVM(SRC, PA) do { _Pragma("unroll") for (int d0 = 0; d0 < 4; ++d0) o[d0] = __builtin_amdgcn_mfma_f32_32x32x16_bf16(PA, \
        ((bf16x8){SRC[2 * d0][0], SRC[2 * d0][1], SRC[2 * d0][2], SRC[2 * d0][3], SRC[2 * d0 + 1][0], SRC[2 * d0 + 1][1], SRC[2 * d0 + 1][2], SRC[2 * d0 + 1][3]}), o[d0], 0, 0, 0); } while (0)
      if (j > 0) VLD(va, 0);
      SBAR();
      asm volatile("v_mfma_f32_32x32x16_bf16 %0, %1, %2, %3" : "=&v"(p0) : "v"(kf[0]), "v"(qr[0]), "v"(negm));
      asm volatile("v_mfma_f32_32x32x16_bf16 %0, %1, %2, %3" : "=&v"(p1) : "v"(kf[1]), "v"(qr[0]), "v"(negm));
      SBAR(); ISSUE1(j + 3, j + 2, 0); SBAR();
#pragma unroll
      for (int d0 = 1; d0 < 4; ++d0) {
        p0 = __builtin_amdgcn_mfma_f32_32x32x16_bf16(kf[2 * d0], qr[d0], p0, 0, 0, 0);
        p1 = __builtin_amdgcn_mfma_f32_32x32x16_bf16(kf[2 * d0 + 1], qr[d0], p1, 0, 0, 0);
        SBAR(); ISSUE1(j + 3, j + 2, d0); SBAR(); }
      if (j > 0) {
        VLD(vbq, 1); SBAR();
        PVM(va, pa0); VLD(va, 2); SBAR();
        PVM(vbq, pa1); VLD(vbq, 3); SBAR();
      }
#undef VLD
    }
    if (js == 1) BAR_VL8();
    if (j > 0) { PVM(va, pa2); PVM(vbq, pa3); }
#undef PVM
    SBAR(); __builtin_amdgcn_s_setprio(0); SBAR();
    float pmaxa = fmaxf(p0[0], p1[0]), pmaxb = fmaxf(p0[1], p1[1]);
#pragma unroll
    for (int r = 2; r < 16; r += 2) { pmaxa = fmaxf(fmaxf(pmaxa, p0[r]), p1[r]); pmaxb = fmaxf(fmaxf(pmaxb, p0[r + 1]), p1[r + 1]); }
    float pmax = fmaxf(pmaxa, pmaxb);
    { auto rr = __builtin_amdgcn_permlane32_swap(__float_as_uint(pmax), __float_as_uint(pmax), false, false);
      pmax = fmaxf(__uint_as_float(rr[0]), __uint_as_float(rr[1])); }
    if (j == 0 || __any(pmax > THRL)) {
      const float dl = (j == 0) ? pmax : fmaxf(pmax, 0.f); m_reg += dl;
#pragma unroll
      for (int r = 0; r < 16; ++r) { p0[r] -= dl; p1[r] -= dl; }
#pragma unroll
      for (int r = 0; r < 16; ++r) negm[r] = -m_reg;
      if (j > 0) { const float al = __builtin_amdgcn_exp2f(-dl); l_reg *= al;
        if (hi == 0) al_l[r32] = al;
        asm volatile("s_waitcnt lgkmcnt(0)" ::: "memory");
#pragma unroll
        for (int d = 0; d < 4; ++d)
#pragma unroll
          for (int r = 0; r < 16; ++r) o[d][r] *= al_l[crow(r, hi)]; }
    }
#pragma unroll
    for (int r = 0; r < 16; ++r) { p0[r] = __builtin_amdgcn_exp2f(p0[r]); p1[r] = __builtin_amdgcn_exp2f(p1[r]); }
    float ps0 = 0.f, ps1 = 0.f, ps2 = 0.f, ps3 = 0.f;
#pragma unroll
    for (int r = 0; r < 16; r += 4) { ps0 += p0[r] + p1[r]; ps1 += p0[r + 1] + p1[r + 1]; ps2 += p0[r + 2] + p1[r + 2]; ps3 += p0[r + 3] + p1[r + 3]; }
    float ps = (ps0 + ps1) + (ps2 + ps3);
    { auto rr = __builtin_amdgcn_permlane32_swap(__float_as_uint(ps), __float_as_uint(ps), false, false);
      ps = __uint_as_float(rr[0]) + __uint_as_float(rr[1]); }
    l_reg += ps;
#define PK4(P, BASE, OUT) do { u32x4 w = {cvtpk(P[BASE + 0], P[BASE + 1]), cvtpk(P[BASE + 2], P[BASE + 3]), cvtpk(P[BASE + 4], P[BASE + 5]), cvtpk(P[BASE + 6], P[BASE + 7])}; OUT = *reinterpret_cast<bf16x8*>(&w); } while (0)
    PK4(p0, 0, pa0); PK4(p0, 8, pa1); PK4(p1, 0, pa2); PK4(p1, 8, pa3);
#undef PK4
    __builtin_amdgcn_s_setprio(1);
    if (js == 0) BAR_VL8();
  }
  pv_all(o, vb0 + ((NT - 1) & 3) * SHM_V, pa0, pa1, pa2, pa3);
  __builtin_amdgcn_s_setprio(0);
  asm volatile("s_waitcnt vmcnt(0) lgkmcnt(0)" ::: "memory");
  if (hi == 0) li_l[r32] = l_reg; asm volatile("s_waitcnt lgkmcnt(0)" ::: "memory");
  float rli[16];
#pragma unroll
  for (int r = 0; r < 16; ++r) rli[r] = __builtin_amdgcn_rcpf(li_l[crow(r, hi)]);
  __syncthreads();
  float* X2 = (float*)lds + qw * (32 * 128);
  if (js == 1) {
#pragma unroll
    for (int r = 0; r < 16; ++r) { const float f = rli[r] * A.lam;
#pragma unroll
      for (int d0 = 0; d0 < 4; ++d0) X2[crow(r, hi) * 128 + d0 * 32 + r32] = o[d0][r] * f; }
  }
  __syncthreads();
  if (js == 0) {
    float gq[4];
#pragma unroll
    for (int d0 = 0; d0 < 4; ++d0) gq[d0] = A.subg[d0 * 32 + r32] * A.oscale;
    bf16_t* Yw = A.YC + (size_t)(qrow0 + qw * QBLK) * LDY + YC_ATT + h * 128 + r32;
#pragma unroll
    for (int r = 0; r < 16; ++r) { float v[4]; float ss = 0.f;
#pragma unroll
      for (int d0 = 0; d0 < 4; ++d0) { v[d0] = o[d0][r] * rli[r] - X2[crow(r, hi) * 128 + d0 * 32 + r32]; ss += v[d0] * v[d0]; }
      ss += __shfl_xor(ss, 1); ss += __shfl_xor(ss, 2); ss += __shfl_xor(ss, 4); ss += __shfl_xor(ss, 8); ss += __shfl_xor(ss, 16);
      const float rn = 1.0f / sqrtf(ss * (1.0f / 128.0f) + 1e-6f);
#pragma unroll
      for (int d0 = 0; d0 < 4; ++d0) { const float y = v[d0] * rn * gq[d0]; Yw[(size_t)crow(r, hi) * LDY + d0 * 32] = (bf16_t)(cvtpk(y, y) & 0xffffu); } }
  }
  asm volatile("s_waitcnt vmcnt(0)" ::: "memory");
  __syncthreads();
#undef TROW
#undef ISSUE
#undef ISSUE1
}
#undef BAR_L
#undef BAR_VL8
#undef KSWZ
#undef SBAR
}
#define GAS __attribute__((address_space(1)))
#define LAS __attribute__((address_space(3)))
typedef unsigned short bf16;
typedef unsigned v4u __attribute__((ext_vector_type(4)));
typedef unsigned v2u __attribute__((ext_vector_type(2)));
typedef float f32x4 __attribute__((ext_vector_type(4)));
typedef short bf16x8 __attribute__((ext_vector_type(8)));
typedef GAS unsigned gu32;
typedef GAS unsigned long long gu64;
#define RLX_AGENT __ATOMIC_RELAXED, __HIP_MEMORY_SCOPE_AGENT
#define LDS_WAIT() asm volatile("s_waitcnt lgkmcnt(0)" ::: "memory")
#define VM_WAIT() asm volatile("s_waitcnt vmcnt(0)" ::: "memory")
__device__ __forceinline__ unsigned long long rt() { return __builtin_amdgcn_s_memrealtime(); }
__device__ __forceinline__ unsigned f2bf(float f) { unsigned u = __builtin_bit_cast(unsigned, f); return (u + 0x7fffu + ((u >> 16) & 1u)) >> 16; }
__device__ __forceinline__ unsigned pk2(float lo, float hi) { return f2bf(lo) | (f2bf(hi) << 16); }
#define XB_TMO      128
#define XB_XCNT(j)  (256  + 64 * (j))
#define XB_XSUB(j)  (1280 + 64 * (j))
#define XB_XGEN(j)  (2304 + 64 * (j))
#define XB_TOP      3328
#define XB_TOPGEN   3392
#define XCD_BAR_WORDS 3456
#define XB_SPIN_CAP (1u << 18)

__device__ __forceinline__ unsigned xb_ld(unsigned* p)              { return __hip_atomic_load(p, __ATOMIC_RELAXED, __HIP_MEMORY_SCOPE_AGENT); }
__device__ __forceinline__ unsigned xb_add(unsigned* p, unsigned v) { return __hip_atomic_fetch_add(p, v, __ATOMIC_RELAXED, __HIP_MEMORY_SCOPE_AGENT); }
__device__ __forceinline__ unsigned xb_xcc_id() { return (unsigned)__builtin_amdgcn_s_getreg((3 << 11) | 20) & 0xFu; }
#define XB_SPIN(cond, bar) do { unsigned _sp = 0; while (cond) { __builtin_amdgcn_s_sleep(1); \
    if ((++_sp & 255u) == 0u) { if (xb_ld(&(bar)[XB_TMO])) break; if (_sp > XB_SPIN_CAP) { atomicAdd(&(bar)[XB_TMO], 1u); break; } } } } while (0)

struct XcdBarrier {
    unsigned* bar; unsigned x;
    volatile LAS unsigned* st;
};

__device__ __forceinline__ XcdBarrier xcd_barrier_post(unsigned* bar, volatile LAS unsigned* st) {
    XcdBarrier b; b.bar = bar; b.x = xb_xcc_id(); b.st = st;
    if (threadIdx.x == 0) (void)xb_add(&bar[XB_XCNT(b.x)], 1u);
    return b;
}
__device__ __forceinline__ void xcd_barrier_complete(unsigned* bar, unsigned x, unsigned& nloc, unsigned& nx) {
    const unsigned G = gridDim.x * gridDim.y * gridDim.z;
    unsigned sum, cnt, mine, sp = 0u;
    for (;;) {
        sum = 0u; cnt = 0u; mine = 0u;
#pragma unroll
        for (unsigned j = 0; j < 16; ++j) { const unsigned c = xb_ld(&bar[XB_XCNT(j)]); sum += c; cnt += (c > 0u) ? 1u : 0u; mine = (j == x) ? c : mine; }
        if (sum == G) break;
        __builtin_amdgcn_s_sleep(1);
        if ((++sp & 255u) == 0u) { if (xb_ld(&bar[XB_TMO])) break; if (sp > XB_SPIN_CAP) { atomicAdd(&bar[XB_TMO], 1u); break; } }
    }
    nloc = mine > 0u ? mine : 1u; nx = cnt > 0u ? cnt : 1u;
}

__device__ __forceinline__ void xcd_barrier(const XcdBarrier& b) {
    asm volatile("s_waitcnt vmcnt(0)" ::: "memory");
    __syncthreads();
    if (threadIdx.x == 0) {
        unsigned* bar = b.bar;
        __builtin_amdgcn_s_waitcnt(0);
        unsigned nloc = b.st[0], nx = b.st[1];
        if (nloc == 0u) { xcd_barrier_complete(bar, b.x, nloc, nx); b.st[0] = nloc; b.st[1] = nx; }
        const unsigned old = xb_add(&bar[XB_XSUB(b.x)], 1u);
        const unsigned gen = old / nloc;
        if (old + 1u == (gen + 1u) * nloc) {
            __builtin_amdgcn_fence(__ATOMIC_RELEASE, "agent");
            asm volatile("s_waitcnt vmcnt(0)" ::: "memory");
            const unsigned og = xb_add(&bar[XB_TOP], 1u);
            const unsigned tg = og / nx;
            if (og + 1u == (tg + 1u) * nx) xb_add(&bar[XB_TOPGEN], 1u);
            else XB_SPIN(xb_ld(&bar[XB_TOPGEN]) == tg, bar);
            __builtin_amdgcn_fence(__ATOMIC_ACQUIRE, "agent");
            xb_add(&bar[XB_XGEN(b.x)], 1u);
            asm volatile("s_waitcnt vmcnt(0)" ::: "memory");
        } else {
            XB_SPIN(xb_ld(&bar[XB_XGEN(b.x)]) == gen, bar);
            __builtin_amdgcn_fence(__ATOMIC_ACQUIRE, "agent");
            asm volatile("s_waitcnt vmcnt(0)" ::: "memory");
        }
    }
    __syncthreads();
}

typedef decltype(__builtin_amdgcn_kernarg_segment_ptr()) kargp_t;
struct Frame {
    LAS unsigned char* lds;
    volatile LAS unsigned* MISC;
    gu32* ctl;
    int tid, lane, wave;
    int vcu, G;
    kargp_t kp;
    float* out;
    unsigned char* ws;
};
#define FIN(i) (((const float* const*)F.kp)[i])
#define WSP(T, off) ((T*)(F.ws + (off)))

__device__ __forceinline__ float wave_sum(float v) {
#pragma unroll
    for (int o = 1; o < 64; o <<= 1) v += __shfl_xor(v, o);
    return v;
}
__device__ __forceinline__ void dsincos(double x, double& s, double& c) {
    const double kd = rint(x * 0.63661977236758134308);
    double r = fma(-kd, 1.57079632679489655800e+00, x); r = fma(-kd, 6.12323399573676603587e-17, r);
    const double r2 = r * r;
    double sp = -1.0 / 1307674368000.0; sp = sp * r2 + 1.0 / 6227020800.0; sp = sp * r2 - 1.0 / 39916800.0; sp = sp * r2 + 1.0 / 362880.0; sp = sp * r2 - 1.0 / 5040.0; sp = sp * r2 + 1.0 / 120.0; sp = sp * r2 - 1.0 / 6.0; sp = sp * r2 * r + r;
    double cp = 1.0 / 20922789888000.0; cp = cp * r2 - 1.0 / 87178291200.0; cp = cp * r2 + 1.0 / 479001600.0; cp = cp * r2 - 1.0 / 3628800.0; cp = cp * r2 + 1.0 / 40320.0; cp = cp * r2 - 1.0 / 720.0; cp = cp * r2 + 1.0 / 24.0; cp = cp * r2 - 0.5; cp = cp * r2 + 1.0;
    const int k = ((int)kd) & 3;
    s = (k == 0) ? sp : (k == 1) ? cp : (k == 2) ? -sp : -cp;
    c = (k == 0) ? cp : (k == 1) ? -sp : (k == 2) ? -cp : sp;
}
__device__ __forceinline__ float silu_f(float a) { return a / (1.0f + __expf(-a)); }

__device__ __forceinline__ void ssm_disc(double dt, float are_f, float aim_f, double& abr, double& abi, double& cfr, double& cfi) {
    const double are = (double)are_f, aim = (double)aim_f, mag = exp(dt * are); double s, c; dsincos(dt * aim, s, c);
    abr = mag * c; abi = mag * s; const double den = are * are + aim * aim, nr = abr - 1.0;
    cfr = (nr * are + abi * aim) / den; cfi = (abi * are - nr * aim) / den;
}
__device__ __forceinline__ void p0_transpose_item(const float* W, int K, int N, bf16* WT, int mode, LAS float* scr, int item, int lane) {
    const int nblk = N / 32, kb = item / nblk, nb = item % nblk, k0 = 64 * kb, n0 = 32 * nb;
#pragma unroll 8
    for (int i = 0; i < 32; ++i) { const int kk = 2 * i + (lane >> 5); scr[kk * 33 + (lane & 31)] = W[(size_t)(k0 + kk) * N + n0 + (lane & 31)]; }
    LDS_WAIT(); asm volatile("" ::: "memory");
    const int c = lane & 7;
#pragma unroll
    for (int j = 0; j < 4; ++j) { const int n = (lane >> 3) + 8 * j; const LAS float* s = scr + (8 * c) * 33 + n;
        v4u o; o.x = pk2(s[0 * 33], s[1 * 33]); o.y = pk2(s[2 * 33], s[3 * 33]); o.z = pk2(s[4 * 33], s[5 * 33]); o.w = pk2(s[6 * 33], s[7 * 33]);
        const int ns = n0 + n; const int drow = (mode == 0) ? ns : ((ns >> 7) * 256 + (mode - 1) * 128 + (ns & 127));
        *(GAS v4u*)(WT + (size_t)drow * K + k0 + 8 * c) = o; }
    LDS_WAIT(); asm volatile("" ::: "memory");
}
constexpr int I_FF1 = (D / 64) * (DFF / 32), I_FF2 = (DFF / 64) * (D / 32), I_IN = (D / 64) * (DIN / 32), I_OUT = (D / 64) * (D / 32), I_GLU = (WSSM / 64) * (WSSM / 32);
constexpr int I_LAYER = 4 * I_FF1 + 2 * I_FF2 + I_IN + I_OUT + I_GLU;
constexpr int SUPER = 64, N_SUPER = 2 * I_LAYER / SUPER;
static_assert((2 * I_LAYER) % SUPER == 0, "super-items");
constexpr int GEMV_COLS = 128, N_GEMV = 2 * (MODW / GEMV_COLS);
__device__ __forceinline__ void p0_convert_item(Frame& F, int it, LAS float* scr) {
    const int l = it / I_LAYER; int r = it % I_LAYER;
    unsigned char* wl = F.ws + WS_W + (size_t)l * W_LAYER;
    if (r < I_FF1) { p0_transpose_item(FIN(6) + (size_t)l * D * DFF, D, DFF, (bf16*)(wl + WL_13A), 1, scr, r, F.lane); return; } r -= I_FF1;
    if (r < I_FF1) { p0_transpose_item(FIN(7) + (size_t)l * D * DFF, D, DFF, (bf16*)(wl + WL_13A), 2, scr, r, F.lane); return; } r -= I_FF1;
    if (r < I_FF2) { p0_transpose_item(FIN(8) + (size_t)l * D * DFF, DFF, D, (bf16*)(wl + WL_2A), 0, scr, r, F.lane); return; } r -= I_FF2;
    if (r < I_FF1) { p0_transpose_item(FIN(9) + (size_t)l * D * DFF, D, DFF, (bf16*)(wl + WL_13B), 1, scr, r, F.lane); return; } r -= I_FF1;
    if (r < I_FF1) { p0_transpose_item(FIN(10) + (size_t)l * D * DFF, D, DFF, (bf16*)(wl + WL_13B), 2, scr, r, F.lane); return; } r -= I_FF1;
    if (r < I_FF2) { p0_transpose_item(FIN(11) + (size_t)l * D * DFF, DFF, D, (bf16*)(wl + WL_2B), 0, scr, r, F.lane); return; } r -= I_FF2;
    if (r < I_IN) { p0_transpose_item(FIN(12) + (size_t)l * D * DIN, D, DIN, (bf16*)(wl + WL_IN), 0, scr, r, F.lane); return; } r -= I_IN;
    if (r < I_OUT) { p0_transpose_item(FIN(13) + (size_t)l * D * D, D, D, (bf16*)(wl + WL_OUT), 0, scr, r, F.lane); return; } r -= I_OUT;
    p0_transpose_item(FIN(28) + (size_t)l * WSSM * WSSM, WSSM, WSSM, (bf16*)(wl + WL_GLU), 0, scr, r, F.lane);
}
__device__ __forceinline__ void p0_gemv_task(Frame& F, int t) {
    const int l = t / (MODW / GEMV_COLS), cb = t % (MODW / GEMV_COLS), col0 = cb * GEMV_COLS;
    const LAS float* sil = (const LAS float*)(F.lds + P0_SIL_OFF);
    LAS float* red = (LAS float*)(F.lds + P0_RED_OFF);
    typedef float f32x2 __attribute__((ext_vector_type(2)));
    const float* wp = FIN(4) + ((size_t)l * D + (size_t)F.wave * 512) * MODW + col0 + 2 * F.lane;
    f32x2 a0 = {0.f, 0.f}, a1 = {0.f, 0.f}, a2 = {0.f, 0.f};
    const int kb = F.wave * 512;
#pragma unroll 8
    for (int k = 0; k < 512; ++k) { const f32x2 w = *(const GAS f32x2*)(wp + (size_t)k * MODW);
        a0 += w * sil[kb + k]; a1 += w * sil[D + kb + k]; a2 += w * sil[2 * D + kb + k]; }
    red[(F.wave * 3 + 0) * GEMV_COLS + 2 * F.lane] = a0.x; red[(F.wave * 3 + 0) * GEMV_COLS + 2 * F.lane + 1] = a0.y;
    red[(F.wave * 3 + 1) * GEMV_COLS + 2 * F.lane] = a1.x; red[(F.wave * 3 + 1) * GEMV_COLS + 2 * F.lane + 1] = a1.y;
    red[(F.wave * 3 + 2) * GEMV_COLS + 2 * F.lane] = a2.x; red[(F.wave * 3 + 2) * GEMV_COLS + 2 * F.lane + 1] = a2.y;
    __syncthreads();
    if (F.tid < 3 * GEMV_COLS) { const int v = F.tid / GEMV_COLS, j = F.tid % GEMV_COLS; float s = 0.f;
#pragma unroll
        for (int w = 0; w < 8; ++w) s += red[(w * 3 + v) * GEMV_COLS + j];
        WSP(float, WS_MOD)[((size_t)l * 3 + v) * MODW + col0 + j] = s + FIN(5)[(size_t)l * MODW + col0 + j]; }
    __syncthreads();
}
__device__ __forceinline__ void p0_prologue(Frame& F, int qword) {
    LAS float* sil = (LAS float*)(F.lds + P0_SIL_OFF);
    for (int i = F.tid; i < 3 * D; i += NWAVES * 64) { const float cv = (i < 2 * D) ? FIN(1)[i] : FIN(3)[i - 2 * D]; sil[i] = silu_f(cv); }
    if (blockIdx.x == 0) {
        for (int i = F.tid; i < 128 * 16; i += NWAVES * 64) { const int pos = i >> 4, k = i & 15;
            const float inv = (float)exp(-(double)k * (9.210340371976184 / 16.0));
            const float ang = (float)pos * inv; double s, c; dsincos((double)ang, s, c);
            WSP(float, WS_ROPE)[pos * 32 + k] = (float)c; WSP(float, WS_ROPE)[pos * 32 + 16 + k] = (float)s; }
    }
    for (int pg = blockIdx.x; pg < 256; pg += F.G) if (F.tid < 64) { const int n = F.tid;
        const double dt = exp((double)FIN(22)[pg]); double abr, abi, cr, ci; ssm_disc(dt, FIN(20)[pg * 64 + n], FIN(21)[pg * 64 + n], abr, abi, cr, ci);
        WSP(float, WS_ABAR)[(pg * 64 + n) * 2] = (float)abr; WSP(float, WS_ABAR)[(pg * 64 + n) * 2 + 1] = (float)abi;
        const float* bre = FIN(23) + ((size_t)pg * 64 + n) * 16; const float* bim = FIN(24) + ((size_t)pg * 64 + n) * 16;
#pragma unroll 4
        for (int p = 0; p < 16; ++p) { WSP(float, WS_BBR)[((size_t)pg * 64 + n) * 16 + p] = (float)(cr * (double)bre[p] - ci * (double)bim[p]);
                                       WSP(float, WS_BBI)[((size_t)pg * 64 + n) * 16 + p] = (float)(cr * (double)bim[p] + ci * (double)bre[p]); } }
    __syncthreads();
    LAS float* scr = (LAS float*)(F.lds + F.wave * 8448);
    LAS unsigned* qslot = (LAS unsigned*)(F.lds + P0_Q_OFF);
    for (;;) {
        if (F.tid == 0) qslot[0] = __hip_atomic_fetch_add(F.ctl + qword, 1u, RLX_AGENT);
        __syncthreads();
        const int t = (int)qslot[0];
        __syncthreads();
        if (t >= N_GEMV + N_SUPER) break;
        if (t < N_GEMV) p0_gemv_task(F, t);
        else { const int base = (t - N_GEMV) * SUPER;
#pragma unroll 1
            for (int i = 0; i < SUPER / NWAVES; ++i) p0_convert_item(F, base + i * NWAVES + F.wave, scr); }
    }
}

__device__ __forceinline__ const float* xrow_ptr(const float* lat, const float* cx, int row) { return row < NLAT ? lat + (size_t)row * D : cx + (size_t)(row - NLAT) * D; }
typedef pg8::f16_t f16_t; typedef pg8::f16x8 f16x8; typedef pg8::f32x8 f32x8;
template <bool X16>
__device__ __forceinline__ void norm_mod_phase(Frame& F, const float* lat, const float* cx, const f16_t* Xs, int nrows, const float* modl, int ish, int isc, bf16* H,
                                               const float* part, const float* pgate, float pscale, const float* pb32, f16_t* Xw) {
    const int gw = F.vcu * NWAVES + F.wave, NGW = F.G * NWAVES; const int c0 = 8 * F.lane;
    LAS float* mlds = (LAS float*)F.lds;
    for (int i = F.tid; i < 3 * 2 * (D / 4); i += NWAVES * 64) { const int set = i / (2 * (D / 4)), r = i % (2 * (D / 4)), which = r / (D / 4), c4 = r % (D / 4);
        ((LAS f32x4*)mlds)[i] = *(const GAS f32x4*)(modl + (size_t)set * MODW + (which ? isc : ish) * D + 4 * c4); }
    __syncthreads();
    for (int row = gw; row < nrows; row += NGW) {
        const int set = row < 8192 ? 0 : (row < NLAT ? 1 : 2);
        const LAS float* sh = mlds + set * (2 * D) + c0; const LAS float* sc = sh + D;
        f32x8 v[8]; float ss = 0.f;
        if (part != nullptr && row >= NLAT) {
            const int rc = row - NLAT;
#pragma unroll
            for (int j = 0; j < 8; ++j) { const int c = c0 + 512 * j; f32x4 s0 = {0.f, 0.f, 0.f, 0.f}, s1 = {0.f, 0.f, 0.f, 0.f};
#pragma unroll
                for (int ks = 0; ks < 8; ++ks) { const float* pp = part + ((size_t)ks * NCTX + rc) * D + c; s0 += *(const GAS f32x4*)pp; s1 += *(const GAS f32x4*)(pp + 4); }
                f32x8 b;
                if (pb32 != nullptr) { const f32x4 b0 = *(const GAS f32x4*)(pb32 + (size_t)rc * D + c), b1 = *(const GAS f32x4*)(pb32 + (size_t)rc * D + c + 4); b = (f32x8){b0[0], b0[1], b0[2], b0[3], b1[0], b1[1], b1[2], b1[3]}; }
                else b = __builtin_convertvector(*(const GAS f16x8*)(Xw + (size_t)row * D + c), f32x8);
                const f32x4 g0 = *(const GAS f32x4*)(pgate + c) * pscale, g1 = *(const GAS f32x4*)(pgate + c + 4) * pscale;
                v[j] = (f32x8){b[0] + g0[0] * s0[0], b[1] + g0[1] * s0[1], b[2] + g0[2] * s0[2], b[3] + g0[3] * s0[3], b[4] + g1[0] * s1[0], b[5] + g1[1] * s1[1], b[6] + g1[2] * s1[2], b[7] + g1[3] * s1[3]};
                *(GAS f16x8*)(Xw + (size_t)row * D + c) = __builtin_convertvector(v[j], f16x8); }
        } else if (X16) {
#pragma unroll
            for (int j = 0; j < 8; ++j) v[j] = __builtin_convertvector(*(const GAS f16x8*)(Xs + (size_t)row * D + c0 + 512 * j), f32x8);
        } else {
            const float* xr = xrow_ptr(lat, cx, row) + c0;
#pragma unroll
            for (int j = 0; j < 8; ++j) { const f32x4 a = *(const GAS f32x4*)(xr + 512 * j), b = *(const GAS f32x4*)(xr + 512 * j + 4); v[j] = (f32x8){a[0], a[1], a[2], a[3], b[0], b[1], b[2], b[3]}; }
        }
#pragma unroll
        for (int j = 0; j < 8; ++j)
#pragma unroll
            for (int x = 0; x < 8; ++x) ss += v[j][x] * v[j][x];
        const float r = 1.0f / sqrtf(wave_sum(ss) * (1.0f / D) + NORM_EPS);
#pragma unroll
        for (int j = 0; j < 8; ++j) { const f32x4 s0 = *(const LAS f32x4*)(sc + 512 * j), s1 = *(const LAS f32x4*)(sc + 512 * j + 4), h0 = *(const LAS f32x4*)(sh + 512 * j), h1 = *(const LAS f32x4*)(sh + 512 * j + 4);
            v4u o; o.x = pk2(v[j][0] * r * (s0[0] + 1.0f) + h0[0], v[j][1] * r * (s0[1] + 1.0f) + h0[1]); o.y = pk2(v[j][2] * r * (s0[2] + 1.0f) + h0[2], v[j][3] * r * (s0[3] + 1.0f) + h0[3]);
            o.z = pk2(v[j][4] * r * (s1[0] + 1.0f) + h1[0], v[j][5] * r * (s1[1] + 1.0f) + h1[1]); o.w = pk2(v[j][6] * r * (s1[2] + 1.0f) + h1[2], v[j][7] * r * (s1[3] + 1.0f) + h1[3]);
            *(GAS v4u*)(H + (size_t)row * D + c0 + 512 * j) = o; }
    }
}
__device__ __forceinline__ void final_norm_phase(Frame& F) {
    const int gw = F.vcu * NWAVES + F.wave, NGW = F.G * NWAVES; const int c0 = 8 * F.lane;
    LAS float* gl = (LAS float*)F.lds;
    for (int i = F.tid; i < D / 4; i += NWAVES * 64) ((LAS f32x4*)gl)[i] = ((const GAS f32x4*)FIN(29))[i];
    __syncthreads();
    const LAS float* gp = gl + c0; const f16_t* Xs = WSP(f16_t, WS_X);
    for (int row = gw; row < NLAT; row += NGW) {
        f32x8 v[8]; float ss = 0.f;
#pragma unroll
        for (int j = 0; j < 8; ++j) v[j] = __builtin_convertvector(*(const GAS f16x8*)(Xs + (size_t)row * D + c0 + 512 * j), f32x8);
#pragma unroll
        for (int j = 0; j < 8; ++j)
#pragma unroll
            for (int x = 0; x < 8; ++x) ss += v[j][x] * v[j][x];
        const float r = 1.0f / sqrtf(wave_sum(ss) * (1.0f / D) + NORM_EPS);
        float* o = F.out + (size_t)row * D + c0;
#pragma unroll
        for (int j = 0; j < 8; ++j) { const f32x4 g0 = *(const LAS f32x4*)(gp + 512 * j), g1 = *(const LAS f32x4*)(gp + 512 * j + 4);
            *(GAS f32x4*)(o + 512 * j) = (f32x4){v[j][0] * r * g0[0], v[j][1] * r * g0[1], v[j][2] * r * g0[2], v[j][3] * r * g0[3]};
            *(GAS f32x4*)(o + 512 * j + 4) = (f32x4){v[j][4] * r * g1[0], v[j][5] * r * g1[1], v[j][6] * r * g1[2], v[j][7] * r * g1[3]}; }
    }
}
__device__ __forceinline__ void unpack8(const v4u w, float (&f)[8]) {
    f[0] = pg8::bf_lo(w.x); f[1] = pg8::bf_hi(w.x); f[2] = pg8::bf_lo(w.y); f[3] = pg8::bf_hi(w.y); f[4] = pg8::bf_lo(w.z); f[5] = pg8::bf_hi(w.z); f[6] = pg8::bf_lo(w.w); f[7] = pg8::bf_hi(w.w);
}
__device__ __forceinline__ void conv_phase(Frame& F, int l, int nrows) {
    const int gw = F.vcu * NWAVES + F.wave, NGW = F.G * NWAVES;
    const bf16* P = WSP(bf16, WS_P); bf16* YC = WSP(bf16, WS_YCAT);
    LAS float* cw = (LAS float*)F.lds;
    for (int i = F.tid; i < 3 * WCONV / 4; i += NWAVES * 64) ((LAS f32x4*)cw)[i] = ((const GAS f32x4*)(FIN(14) + (size_t)l * 3 * WCONV))[i];
    __syncthreads();
    for (int row = gw; row < nrows; row += NGW) {
        int t, len; if (row < NLAT) { t = row & 8191; len = 8192; } else { t = (row - NLAT) & 255; len = 256; }
        const bool hp = t > 0, hn = t + 1 < len;
#pragma unroll
        for (int hv = 0; hv < 2; ++hv) { const int c0 = F.lane * 16 + hv * 8;
            const bf16* p0 = P + (size_t)row * LDP + c0;
            float h0[8], b0[8], g0[8], hm[8], gm[8], hq[8], gq[8];
            unpack8(*(const GAS v4u*)(p0), h0); unpack8(*(const GAS v4u*)(p0 + WCONV), b0); unpack8(*(const GAS v4u*)(p0 + 2 * WCONV), g0);
            if (hp) { unpack8(*(const GAS v4u*)(p0 - LDP), hm); unpack8(*(const GAS v4u*)(p0 - LDP + 2 * WCONV), gm); }
            if (hn) { unpack8(*(const GAS v4u*)(p0 + LDP), hq); unpack8(*(const GAS v4u*)(p0 + LDP + 2 * WCONV), gq); }
            float o[8];
#pragma unroll
            for (int x = 0; x < 8; ++x) { const float zm = hp ? gm[x] * hm[x] : 0.f, z0 = g0[x] * h0[x], zq = hn ? gq[x] * hq[x] : 0.f;
                o[x] = b0[x] * (zm * cw[c0 + x] + z0 * cw[WCONV + c0 + x] + zq * cw[2 * WCONV + c0 + x]); }
            v4u w; w.x = pk2(o[0], o[1]); w.y = pk2(o[2], o[3]); w.z = pk2(o[4], o[5]); w.w = pk2(o[6], o[7]);
            *(GAS v4u*)(YC + (size_t)row * D + c0) = w; }
    }
}
__device__ __forceinline__ float gelu_tanh(float y) { const float u = 1.5957691216057308f * (y + 0.044715f * y * y * y); return y / (1.0f + __expf(-u)); }
__device__ __forceinline__ void ssm_combine_phase(Frame& F, int l, int nrows) {
    const bf16* P = WSP(bf16, WS_P); const bf16* YF = WSP(bf16, WS_YF); const bf16* YR = WSP(bf16, WS_YR); bf16* YP = WSP(bf16, WS_YPRE);
    const float* dsk = FIN(27) + (size_t)l * WSSM;
    const size_t total = (size_t)nrows * (WSSM / 8), stride = (size_t)F.G * NWAVES * 64;
    for (size_t i = (size_t)F.vcu * NWAVES * 64 + F.tid; i < total; i += stride) { const size_t row = i >> 7; const int c = (int)(i & 127) * 8;
        float u[8]; unpack8(*(const GAS v4u*)(P + row * LDP + OFF_U + c), u);
        float ff[8], rr[8]; unpack8(*(const GAS v4u*)(YF + row * WSSM + c), ff); unpack8(*(const GAS v4u*)(YR + row * WSSM + c), rr);
        const f32x4 f0 = {ff[0], ff[1], ff[2], ff[3]}, f1 = {ff[4], ff[5], ff[6], ff[7]}, r0 = {rr[0], rr[1], rr[2], rr[3]}, r1 = {rr[4], rr[5], rr[6], rr[7]};
        const f32x4 d0 = *(const GAS f32x4*)(dsk + c), d1 = *(const GAS f32x4*)(dsk + c + 4);
        float y[8];
        y[0] = d0.x * u[0] + f0.x + r0.x; y[1] = d0.y * u[1] + f0.y + r0.y; y[2] = d0.z * u[2] + f0.z + r0.z; y[3] = d0.w * u[3] + f0.w + r0.w;
        y[4] = d1.x * u[4] + f1.x + r1.x; y[5] = d1.y * u[5] + f1.y + r1.y; y[6] = d1.z * u[6] + f1.z + r1.z; y[7] = d1.w * u[7] + f1.w + r1.w;
#pragma unroll
        for (int x = 0; x < 8; ++x) y[x] = gelu_tanh(y[x]);
        v4u w; w.x = pk2(y[0], y[1]); w.y = pk2(y[2], y[3]); w.z = pk2(y[4], y[5]); w.w = pk2(y[6], y[7]);
        *(GAS v4u*)(YP + row * WSSM + c) = w; }
}

__device__ __forceinline__ int ssm_row(int si, int dir, int b) {
    if (si < CTXL) return NLAT + b * CTXL + (dir ? CTXL - 1 - si : si);
    const int li = si - CTXL; return b * SEQ + (dir ? SEQ - 1 - li : li);
}
__device__ __forceinline__ void split8(const float (&v)[8], bf16x8& hi8, bf16x8& lo8) {
    v4u h, lo; float rs[8];
    h.x = pg8::cvt_pk_bf16(v[0], v[1]); h.y = pg8::cvt_pk_bf16(v[2], v[3]); h.z = pg8::cvt_pk_bf16(v[4], v[5]); h.w = pg8::cvt_pk_bf16(v[6], v[7]);
    rs[0] = v[0] - pg8::bf_lo(h.x); rs[1] = v[1] - pg8::bf_hi(h.x); rs[2] = v[2] - pg8::bf_lo(h.y); rs[3] = v[3] - pg8::bf_hi(h.y);
    rs[4] = v[4] - pg8::bf_lo(h.z); rs[5] = v[5] - pg8::bf_hi(h.z); rs[6] = v[6] - pg8::bf_lo(h.w); rs[7] = v[7] - pg8::bf_hi(h.w);
    lo.x = pg8::cvt_pk_bf16(rs[0], rs[1]); lo.y = pg8::cvt_pk_bf16(rs[2], rs[3]); lo.z = pg8::cvt_pk_bf16(rs[4], rs[5]); lo.w = pg8::cvt_pk_bf16(rs[6], rs[7]);
    hi8 = __builtin_bit_cast(bf16x8, h); lo8 = __builtin_bit_cast(bf16x8, lo);
}
__device__ __forceinline__ int crow16(int r, int hi) { return (r & 3) + 8 * (r >> 2) + 4 * hi; }
template <int ABL = 0> __device__ __forceinline__ void ssm_task(Frame& F, int l, int task) {
    typedef float f32x16 __attribute__((ext_vector_type(16)));
    typedef float f32x2 __attribute__((ext_vector_type(2)));
    constexpr int NCH = (CTXL + SEQ) / 64, HS = 132;
    const int b = task >> 7, dir = (task >> 6) & 1, g = task & 63, pg = (l * 2 + dir) * 64 + g;
    const int wv = F.wave, lane = F.lane, r32 = lane & 31, hi = lane >> 5, fr = lane & 15, fq = lane >> 4;
    const int w = (wv == 0) ? 0 : (wv <= 3) ? wv : (wv == 5) ? 4 : (wv == 4) ? 9 : (wv == 6) ? 5 : 6;
    LAS float* BU = (LAS float*)(F.lds);
    LAS float* HB = (LAS float*)(F.lds + 65536);
    const bf16* P = WSP(bf16, WS_P); bf16* Yout = ABL ? WSP(bf16, WS_HID) : (dir ? WSP(bf16, WS_YR) : WSP(bf16, WS_YF));
    f32x2 aa = {0.f, 0.f}, na = {0.f, 0.f}, h = {0.f, 0.f};
    bf16x8 Rh[4], Rl[4];
#pragma unroll
    for (int q = 0; q < 4; ++q) { Rh[q] = bf16x8{}; Rl[q] = bf16x8{}; }
    if (w == 0) { const float ar = WSP(float, WS_ABAR)[(pg * 64 + lane) * 2], ai = WSP(float, WS_ABAR)[(pg * 64 + lane) * 2 + 1]; aa = (f32x2){ar, ar}; na = (f32x2){-ai, ai}; }
    else if (w <= 4) {
        const float* cre = FIN(25) + ((size_t)pg * 16 + fr) * 64; const float* cim = FIN(26) + ((size_t)pg * 16 + fr) * 64;
#pragma unroll
        for (int ks = 0; ks < 4; ++ks) { float v[8];
#pragma unroll
            for (int x = 0; x < 8; ++x) { const int n = 16 * ks + 4 * fq + (x >> 1); v[x] = (x & 1) ? -cim[n] : cre[n]; }
            split8(v, Rh[ks], Rl[ks]); }
    } else if (w <= 6) {
#pragma unroll
        for (int nb = 0; nb < 4; ++nb) { const int n = 32 * (nb & 1) + r32;
            const float* bb = ((nb < 2) ? WSP(float, WS_BBR) : WSP(float, WS_BBI)) + ((size_t)pg * 64 + n) * 16 + 8 * hi; float v[8];
#pragma unroll
            for (int x = 0; x < 8; ++x) v[x] = bb[x];
            split8(v, Rh[nb], Rl[nb]); }
    }
#define SSM_UDMA(CH) do { const int ch_ = (CH) < NCH ? (CH) : NCH - 1; _Pragma("unroll") for (int i_ = 0; i_ < 2; ++i_) { \
        const bf16* src_ = P + (size_t)ssm_row(64 * ch_ + 32 * i_ + (lane >> 1), dir, b) * LDP + OFF_U + 16 * g + 8 * (lane & 1); \
        att::glds16(src_, (unsigned)__builtin_amdgcn_readfirstlane(uring0 + ((CH) & 3) * 2048 + i_ * 1024)); } } while (0)
    const unsigned uring0 = (unsigned)(uintptr_t)(F.lds + SSM_URING_OFF);
    if (w == 6) { SSM_UDMA(0); SSM_UDMA(1); SSM_UDMA(2); asm volatile("s_waitcnt vmcnt(4)" ::: "memory"); }
    __syncthreads();
    for (int c = -1; c <= NCH; ++c) {
        if (w == 0) {
            if (ABL != 1 && ABL != 4 && c >= 0 && c < NCH) { const LAS f32x2* bu = (const LAS f32x2*)(BU + (c & 1) * (64 * 128)) + lane; LAS f32x2* hb = (LAS f32x2*)(HB + (c & 1) * (64 * HS)) + lane;
                f32x2 cur[16], nxt[16];
#pragma unroll
                for (int q = 0; q < 16; ++q) cur[q] = bu[q * 64];
#pragma unroll
                for (int blk = 0; blk < 4; ++blk) {
                    if (blk < 3) {
#pragma unroll
                        for (int q = 0; q < 16; ++q) nxt[q] = bu[(16 * (blk + 1) + q) * 64]; }
#pragma unroll
                    for (int q = 0; q < 16; ++q) { const f32x2 hs = {h.y, h.x}; const f32x2 t = na * hs + cur[q]; h = aa * h + t; hb[(16 * blk + q) * (HS / 2)] = h; }
#pragma unroll
                    for (int q = 0; q < 16; ++q) cur[q] = nxt[q];
                } }
        } else if (w <= 4) {
            if (ABL != 2 && ABL != 4 && c >= 1) { const int ch = c - 1, rb = w - 1; const LAS float* hrow = HB + (ch & 1) * (64 * HS) + (16 * rb + fr) * HS + 8 * fq;
                f32x4 acc = {0.f, 0.f, 0.f, 0.f};
#pragma unroll
                for (int ks = 0; ks < 4; ++ks) { const f32x4 x0 = *(const LAS f32x4*)(hrow + 32 * ks), x1 = *(const LAS f32x4*)(hrow + 32 * ks + 4);
                    const float v[8] = {x0.x, x0.y, x0.z, x0.w, x1.x, x1.y, x1.z, x1.w}; bf16x8 Hh, Hl; split8(v, Hh, Hl);
                    acc = __builtin_amdgcn_mfma_f32_16x16x32_bf16(Rh[ks], Hh, acc, 0, 0, 0);
                    acc = __builtin_amdgcn_mfma_f32_16x16x32_bf16(Rl[ks], Hh, acc, 0, 0, 0);
                    acc = __builtin_amdgcn_mfma_f32_16x16x32_bf16(Rh[ks], Hl, acc, 0, 0, 0); }
                const int row = ssm_row(64 * ch + 16 * rb + fr, dir, b);
                v2u yo; yo.x = pg8::cvt_pk_bf16(acc.x, acc.y); yo.y = pg8::cvt_pk_bf16(acc.z, acc.w);
                *(GAS v2u*)(Yout + (size_t)row * WSSM + 16 * g + 4 * fq) = yo; }
        } else if (w <= 6) {
            if (w == 6) SSM_UDMA(c + 4);
            if (ABL != 3 && ABL != 4 && c + 1 < NCH) { const int ch = c + 1; const LAS unsigned char* us = F.lds + SSM_URING_OFF + (ch & 3) * 2048 + r32 * 32 + hi * 16;
                const bf16x8 a0 = *(const LAS bf16x8*)us, a1 = *(const LAS bf16x8*)(us + 1024);
                LAS float* buw = BU + (ch & 1) * (64 * 128);
#pragma unroll
                for (int ti = 0; ti < 8; ++ti) if (ti / 4 == w - 5) { const int sb = ti >> 2, nb = ti & 3;
                    f32x16 d = {}; d = __builtin_amdgcn_mfma_f32_32x32x16_bf16(sb ? a1 : a0, Rh[nb], d, 0, 0, 0); d = __builtin_amdgcn_mfma_f32_32x32x16_bf16(sb ? a1 : a0, Rl[nb], d, 0, 0, 0);
                    LAS float* dst = buw + (32 * sb) * 128 + 2 * (32 * (nb & 1) + r32) + (nb >> 1);
#pragma unroll
                    for (int r = 0; r < 16; ++r) dst[crow16(r, hi) * 128] = d[r]; } }
            if (w == 6) asm volatile("s_waitcnt vmcnt(4)" ::: "memory");
        }
        __syncthreads();
    }
    if (w == 6) asm volatile("s_waitcnt vmcnt(0)" ::: "memory");
    __syncthreads();
#undef SSM_UDMA
}

__device__ __forceinline__ void phase_stagger(int c, unsigned ticks_per_group) {
    const unsigned long long t0 = __builtin_amdgcn_s_memrealtime(); const unsigned long long want = (unsigned long long)((unsigned)(c & 3) * ticks_per_group);
    while (__builtin_amdgcn_s_memrealtime() - t0 < want) __builtin_amdgcn_s_sleep(16);
}
#ifndef PROBE_REP_NORM
#define PROBE_REP_NORM 1
#endif
#ifndef PROBE_REP_G1
#define PROBE_REP_G1 1
#endif
#ifndef STAGGER_TICKS
#define STAGGER_TICKS 650u
#endif
#ifndef PROBE_REP_P0
#define PROBE_REP_P0 1
#endif
#ifndef PROBE_REP_G2
#define PROBE_REP_G2 1
#endif
#ifndef PROBE_REP_G4
#define PROBE_REP_G4 1
#endif
#ifndef PROBE_REP_G3
#define PROBE_REP_G3 1
#endif
#ifndef PROBE_REP_SSM
#define PROBE_REP_SSM 1
#endif
#ifndef PROBE_REP_ATT
#define PROBE_REP_ATT 1
#endif
#ifndef PROBE_REP_GLU
#define PROBE_REP_GLU 1
#endif
struct Args { const float* in[NIN]; float* out; unsigned char* ws; int ph_lo, ph_hi; };
constexpr int N_PHASES = 26;
__global__ void __launch_bounds__(NWAVES * 64, 2) fwd_kernel(Args args) {
    extern __shared__ __attribute__((aligned(16))) unsigned char lds[];
    Frame F;
    F.lds = (LAS unsigned char*)lds;
    F.MISC = (volatile LAS unsigned*)(F.lds + MISC_OFF);
    F.tid = threadIdx.x; F.lane = F.tid & 63; F.wave = __builtin_amdgcn_readfirstlane(F.tid >> 6);
    F.G = gridDim.x; { const int bx = blockIdx.x; F.vcu = (F.G % 8 == 0) ? (bx % 8) * (F.G / 8) + bx / 8 : bx; }
    F.ws = args.ws; F.out = args.out; F.ctl = (gu32*)(args.ws + WS_CTL); F.kp = __builtin_amdgcn_kernarg_segment_ptr();
#define PHASE_ENTER() do { int t_ = threadIdx.x; asm volatile("" : "+v"(t_)); F.tid = t_; F.lane = t_ & 63; F.wave = __builtin_amdgcn_readfirstlane(t_ >> 6); \
        kargp_t k_ = __builtin_amdgcn_kernarg_segment_ptr(); asm volatile("" : "+s"(k_)); F.kp = k_; } while (0)
    for (int u = F.tid; u < (LDS_BYTES - LDSCTL_OFF) / 4; u += NWAVES * 64) ((LAS unsigned*)(F.lds + LDSCTL_OFF))[u] = 0u;
    __syncthreads();
    const int lo = args.ph_lo, hi = args.ph_hi;
    XcdBarrier bar; bar.bar = (unsigned*)(F.ctl + CW_BAR); bar.x = 0; bar.st = nullptr;
    if (hi - lo > 1) bar = xcd_barrier_post((unsigned*)(F.ctl + CW_BAR), F.MISC + 8);
#define IN(k) (lo <= (k) && (k) < hi)
#define INP(k) (IN(k) && ({ PHASE_ENTER(); true; }))
#ifndef PROBE_REP_BAR
#define PROBE_REP_BAR 1
#endif
#define SEAM(k) do { if (IN(k) && IN((k) + 1)) for (int rb_ = 0; rb_ < PROBE_REP_BAR; ++rb_) xcd_barrier(bar); } while (0)


#ifndef PROBE_CLOCK_GBLK
#define PROBE_CLOCK_GBLK 0
#endif
#ifdef PROBE_CLOCK
#define CLK_A(slot) do { if (blockIdx.x == 0 && threadIdx.x == 0) { const unsigned long long t_ = __builtin_amdgcn_s_memtime(), r_ = __builtin_amdgcn_s_memrealtime(); \
        F.MISC[32 + 4 * (slot)] = (unsigned)t_; F.MISC[33 + 4 * (slot)] = (unsigned)(t_ >> 32); F.MISC[34 + 4 * (slot)] = (unsigned)r_; F.MISC[35 + 4 * (slot)] = (unsigned)(r_ >> 32); } } while (0)
#define CLK_B(slot) do { if (blockIdx.x == 0 && threadIdx.x == 0) { const unsigned long long t_ = __builtin_amdgcn_s_memtime(), r_ = __builtin_amdgcn_s_memrealtime(); \
        const unsigned long long t0_ = (unsigned long long)F.MISC[32 + 4 * (slot)] | ((unsigned long long)F.MISC[33 + 4 * (slot)] << 32), r0_ = (unsigned long long)F.MISC[34 + 4 * (slot)] | ((unsigned long long)F.MISC[35 + 4 * (slot)] << 32); \
        F.MISC[48 + (slot)] = (unsigned)((float)(t_ - t0_) * 100.0f / (float)(r_ - r0_)); } } while (0)
#else
#define CLK_A(slot) do {} while (0)
#define CLK_B(slot) do {} while (0)
#endif
    #ifndef SKIP_P0
    if (INP(0)) { p0_prologue(F, CW_QUEUE); for (int rep_ = 1; rep_ < PROBE_REP_P0; ++rep_) p0_prologue(F, CW_QUEUE + 64 * rep_); }
#endif
    SEAM(0);

    f16_t* X = WSP(f16_t, WS_X); bf16* H = WSP(bf16, WS_H); bf16* HID = WSP(bf16, WS_HID); bf16* P = WSP(bf16, WS_P); bf16* YC = WSP(bf16, WS_YCAT); bf16* YP = WSP(bf16, WS_YPRE);
    for (int blk = 0; blk < 6; ++blk) {
        const int l = blk / 3, kind = blk % 3;
        const float* modl = WSP(float, WS_MOD) + (size_t)l * 3 * MODW;
        unsigned char* wl = F.ws + WS_W + (size_t)l * W_LAYER;
        const bool pend = (blk >= 1 && blk <= 4);
        const int pk = (blk + 2) % 3, plr = (blk >= 1) ? (blk - 1) / 3 : 0;
        const float* pgate = WSP(float, WS_MOD) + (size_t)plr * 3 * MODW + 2 * MODW + (pk == 0 ? 2 : (pk == 1 ? 5 : 8)) * D;
        const float pscale = (pk == 1) ? 1.0f : 0.5f;
        const float* part = pend ? WSP(float, WS_PART) : nullptr;
        if (kind != 1) {
            const int pb = 1 + 12 * l + (kind == 2 ? 9 : 0);
            const int Mx = (blk == 5) ? NLAT : MROWS;
            const bool first = (blk == 0);
            const float* xl = first ? FIN(0) : nullptr; const float* xc = first ? FIN(2) : nullptr;
            const int im = (kind == 0) ? 0 : 6;
#ifndef SKIP_NORM
            if (INP(pb)) { if (first) norm_mod_phase<false>(F, xl, xc, X, Mx, modl, im, im + 1, H, nullptr, pgate, pscale, nullptr, X);
                           else for (int rep_ = 0; rep_ < PROBE_REP_NORM; ++rep_) norm_mod_phase<true>(F, nullptr, nullptr, X, Mx, modl, im, im + 1, H, part, pgate, pscale, nullptr, X); }
#endif
            SEAM(pb);
#ifndef SKIP_G1
            if (INP(pb + 1)) { if (blk == PROBE_CLOCK_GBLK) CLK_A(0); pg8::Gemm g{H, (const bf16*)(wl + (kind == 0 ? WL_13A : WL_13B)), Mx, 2 * DFF, D}; pg8::HandoffOrder<2, 30> S; S.init(NLAT, Mx - NLAT, 2 * DFF, D, F.G, (int)blockIdx.x, WSP(float, WS_PART), CW_FLAG + blk * 256);
                pg8::EpiSwiGLU E{HID, DFF};
                for (int rep_ = 0; rep_ < PROBE_REP_G1; ++rep_) pg8::gemm_phase<pg8::EpiSwiGLU, pg8::HandoffOrder<2, 30>, true, true>(F.lds, g, S, E); if (blk == PROBE_CLOCK_GBLK) CLK_B(0); }
#endif
            SEAM(pb + 1);
#ifndef SKIP_G2
            if (INP(pb + 2)) { pg8::Gemm g{HID, (const bf16*)(wl + (kind == 0 ? WL_2A : WL_2B)), Mx, D, DFF}; pg8::SplitOrder S; S.init(NLAT, Mx - NLAT, D, DFF, 8, F.G, (int)blockIdx.x);
                pg8::EpiResid E{xl, xc, X, modl + (im + 2) * D, 0.5f, WSP(float, WS_PART)};
#if defined(PROBE_G2_NULLEPI)
                for (int rep_ = 1; rep_ < PROBE_REP_G2; ++rep_) { pg8::EpiNull E2{WSP(float, WS_P)}; pg8::gemm_phase<pg8::EpiNull, pg8::SplitOrder, true, true>(F.lds, g, S, E2); }
#else
                for (int rep_ = 1; rep_ < PROBE_REP_G2; ++rep_) { pg8::EpiResid E2{xl, xc, WSP(f16_t, WS_P), modl + (im + 2) * D, 0.5f, WSP(float, WS_PART)}; pg8::gemm_phase<pg8::EpiResid, pg8::SplitOrder, true, true>(F.lds, g, S, E2); }
#endif
                pg8::gemm_phase<pg8::EpiResid, pg8::SplitOrder, true, true>(F.lds, g, S, E); }
#endif
            SEAM(pb + 2);
        } else {
            const int pb = 1 + 12 * l + 3;
            const int Mo = (l == 1) ? NLAT : MROWS;
#ifndef SKIP_NORM
            if (INP(pb)) for (int rep_ = 0; rep_ < PROBE_REP_NORM; ++rep_) norm_mod_phase<true>(F, nullptr, nullptr, X, MROWS, modl, 3, 4, H, part, pgate, pscale, (blk == 1) ? FIN(2) : nullptr, X);
#endif
            SEAM(pb);
#ifndef SKIP_G3
            if (INP(pb + 1)) { pg8::Gemm g{H, (const bf16*)(wl + WL_IN), MROWS, DIN, D}; pg8::HandoffOrder<3, 20> S; S.init(NLAT, NCTX, DIN, D, F.G, (int)blockIdx.x, WSP(float, WS_PART), CW_FLAG + blk * 256);
                pg8::EpiRope E{P, DIN, WSP(float, WS_ROPE)};
                for (int rep_ = 0; rep_ < PROBE_REP_G3; ++rep_) pg8::gemm_phase<pg8::EpiRope, pg8::HandoffOrder<3, 20>, true, true>(F.lds, g, S, E); }
#endif
            SEAM(pb + 1);
            if (INP(pb + 2)) {
#ifndef SKIP_SSM
#ifdef PROBE_SSM_ABL
                for (int t = blockIdx.x; t < 256; t += F.G) ssm_task<PROBE_SSM_ABL>(F, l, t);
#endif
                for (int rep_ = 0; rep_ < PROBE_REP_SSM; ++rep_) for (int t = blockIdx.x; t < 256; t += F.G) ssm_task<0>(F, l, t);
#endif
#ifndef SKIP_CONV
                for (int rep_ = 0; rep_ < PROBE_REP_NORM; ++rep_) conv_phase(F, l, Mo);
#endif
            }
            SEAM(pb + 2);
#ifndef SKIP_COMB
            if (INP(pb + 3)) for (int rep_ = 0; rep_ < PROBE_REP_NORM; ++rep_) ssm_combine_phase(F, l, Mo);
#endif
            SEAM(pb + 3);
            if (INP(pb + 4)) {
#ifndef SKIP_ATT
                const float d1 = wave_sum(FIN(15)[l * 64 + F.lane] * FIN(16)[l * 64 + F.lane]), d2 = wave_sum(FIN(17)[l * 64 + F.lane] * FIN(18)[l * 64 + F.lane]);
                const float lam_init = (l == 0) ? 0.2f : 0.355509067590969f;
                att::AttnArgs A{P, YC, FIN(19) + l * 128, __expf(d1) - __expf(d2) + lam_init, 1.0f - lam_init};
                const int nunits = (l == 0) ? 2048 + 64 : 2048;
                if (l == 0) CLK_A(1);
                for (int rep_ = 0; rep_ < PROBE_REP_ATT; ++rep_) for (int e = F.vcu; e < nunits; e += F.G) {
                    if (e < 2048) { const int bh = e >> 6, qb = e & 63, b = bh >> 4, h = bh & 15;
                        att::attn_unit(A, b * SEQ + qb * 128, h, b * SEQ, SEQ / 64, NLAT + b * CTXL, (SEQ + CTXL) / 64, (char*)lds); }
                    else { const int e2 = e - 2048, bh = e2 >> 1, qb = e2 & 1, b = bh >> 4, h = bh & 15;
                        att::attn_unit(A, NLAT + b * CTXL + qb * 128, h, 0, 0, NLAT + b * CTXL, CTXL / 64, (char*)lds); }
                }
                if (l == 0) CLK_B(1);
#endif
#ifndef SKIP_GLU
                pg8::Gemm g{YP, (const bf16*)(wl + WL_GLU), Mo, WSSM, WSSM}; pg8::StaticOrder S; S.init(Mo, WSSM, F.G, (int)blockIdx.x);
                pg8::EpiGlu E{YP, WSSM, YC, D, WCONV + WATT};
                for (int rep_ = 0; rep_ < PROBE_REP_GLU; ++rep_) pg8::gemm_phase<pg8::EpiGlu, pg8::StaticOrder, true, true>(F.lds, g, S, E);
#endif
            }
            SEAM(pb + 4);
#ifndef SKIP_G4
            if (INP(pb + 5)) { pg8::Gemm g{YC, (const bf16*)(wl + WL_OUT), Mo, D, D}; pg8::SplitOrder S; S.init(NLAT, Mo - NLAT, D, D, 8, F.G, (int)blockIdx.x);
                pg8::EpiResid E{nullptr, nullptr, X, modl + 5 * D, 1.0f, WSP(float, WS_PART)};
                for (int rep_ = 1; rep_ < PROBE_REP_G4; ++rep_) { pg8::EpiResid E2{nullptr, nullptr, WSP(f16_t, WS_P), modl + 5 * D, 1.0f, WSP(float, WS_PART)}; pg8::gemm_phase<pg8::EpiResid, pg8::SplitOrder, true, true>(F.lds, g, S, E2); }
                pg8::gemm_phase<pg8::EpiResid, pg8::SplitOrder, true, true>(F.lds, g, S, E); }
#endif
            SEAM(pb + 5);
        }
    }
#ifndef SKIP_FIN
    if (INP(25)) final_norm_phase(F);
#endif
#ifdef PROBE_CLOCK
    if (blockIdx.x == 0 && threadIdx.x == 0) { const unsigned g_ = F.MISC[48], a_ = F.MISC[49];
        const unsigned long long ticks = (unsigned long long)(((g_ + 25u) / 50u) * 3000u + a_) * 100ull, s_ = __builtin_amdgcn_s_memrealtime();
        while (__builtin_amdgcn_s_memrealtime() - s_ < ticks) __builtin_amdgcn_s_sleep(32); }
#endif
#undef IN
#undef SEAM
}

#ifndef MK_ONE_LAUNCH
#define MK_ONE_LAUNCH 1
#endif
extern "C" void kernel_launch(void* const* d_in, const int* in_sizes, int n_in, void* d_out, int out_size, void* d_ws, size_t ws_size, hipStream_t stream) {
    static int grid = 0;
    if (grid == 0) {
        if (n_in != NIN || in_sizes[0] != NLAT * D || out_size != NLAT * D || ws_size < WS_END) {
            fprintf(stderr, "kernel_launch: shape mismatch: n_in %d in0 %d out %d ws %zu (need %zu)\n", n_in, n_in > 0 ? in_sizes[0] : -1, out_size, ws_size, (size_t)WS_END); grid = -1; return; }
        int dev = 0, cus = 0, per_cu = 0;
        if (hipGetDevice(&dev) != hipSuccess || hipDeviceGetAttribute(&cus, hipDeviceAttributeMultiprocessorCount, dev) != hipSuccess) { fprintf(stderr, "kernel_launch: device query failed\n"); grid = -1; return; }
        if (hipFuncSetAttribute((const void*)fwd_kernel, hipFuncAttributeMaxDynamicSharedMemorySize, LDS_BYTES) != hipSuccess) { fprintf(stderr, "kernel_launch: hipFuncSetAttribute failed\n"); grid = -1; return; }
        if (hipOccupancyMaxActiveBlocksPerMultiprocessor(&per_cu, (const void*)fwd_kernel, NWAVES * 64, LDS_BYTES) != hipSuccess || per_cu < 1)
            fprintf(stderr, "kernel_launch: note: occupancy query reports %d workgroups per CU\n", per_cu);
        (void)hipGetLastError();
        grid = cus;
    }
    if (grid < 0) return;
    if (hipMemsetAsync((char*)d_ws + WS_CTL, 0, CTL_ZERO_BYTES, stream) != hipSuccess) { fprintf(stderr, "kernel_launch: memset failed\n"); return; }
    Args a{};
    for (int i = 0; i < NIN; ++i) a.in[i] = (const float*)d_in[i];
    a.out = (float*)d_out; a.ws = (unsigned char*)d_ws;
#if MK_ONE_LAUNCH
    a.ph_lo = 0; a.ph_hi = N_PHASES;
    hipLaunchKernelGGL(fwd_kernel, dim3(grid), dim3(NWAVES * 64), LDS_BYTES, stream, a);
#else
    for (int p = 0; p < N_PHASES; ++p) { a.ph_lo = p; a.ph_hi = p + 1;
        hipLaunchKernelGGL(fwd_kernel, dim3(grid), dim3(NWAVES * 64), LDS_BYTES, stream, a); }
#endif
    const hipError_t le = hipPeekAtLastError();
    if (le != hipSuccess) fprintf(stderr, "kernel_launch: launch failed: %s\n", hipGetErrorName(le));
}
```

```cpp
#include <hip/hip_runtime.h>
#include <hip/hip_bf16.h>
#include <cstdio>
#include <cstdint>
#include <cstddef>
#include <cmath>
constexpr int NIN = 30;
constexpr int D = 4096, BATCH = 2, SEQ = 8192, CTXL = 256, DFF = 8192, NLAT = BATCH * SEQ, NCTX = BATCH * CTXL, MROWS = NLAT + NCTX;
constexpr int WCONV = 1024, WATT = 2048, WSSM = 1024, DIN = 10240, LDP = DIN, OFF_U = 9216, MODW = 9 * D;
constexpr float NORM_EPS = 1e-6f;
constexpr int NWAVES = 8;
constexpr size_t MiB = 1u << 20;
constexpr size_t WS_CTL = 0, CTL_ZERO_BYTES = 1 * MiB;
constexpr size_t WS_MOD = 1 * MiB;
constexpr size_t WS_ROPE = 2 * MiB;
constexpr size_t WS_W = 4 * MiB, W_LAYER = 498 * MiB;
constexpr size_t WL_13A = 0, WL_2A = 128 * MiB, WL_13B = 192 * MiB, WL_2B = 320 * MiB, WL_IN = 384 * MiB, WL_OUT = 464 * MiB, WL_GLU = 496 * MiB;
constexpr size_t WS_X = 1000 * MiB;
constexpr size_t WS_H = 1264 * MiB;
constexpr size_t WS_HID = 1396 * MiB;
constexpr size_t WS_P = 1660 * MiB;
constexpr size_t WS_YCAT = 1990 * MiB;
constexpr size_t WS_YF = 2122 * MiB, WS_YR = 2188 * MiB;
constexpr size_t WS_YPRE = 2254 * MiB;
constexpr size_t WS_ABAR = 2287 * MiB;
constexpr size_t WS_BBR = 2288 * MiB, WS_BBI = 2289 * MiB;
constexpr size_t WS_PART = 2290 * MiB;
constexpr size_t WS_END = 2354 * MiB;
static_assert(WS_W + 2 * W_LAYER <= WS_X && WS_X + (size_t)MROWS * D * 4 <= WS_H && WS_H + (size_t)MROWS * D * 2 <= WS_HID && WS_HID + (size_t)MROWS * DFF * 2 <= WS_P &&
              WS_P + (size_t)MROWS * DIN * 2 <= WS_YCAT && WS_YCAT + (size_t)MROWS * D * 2 <= WS_YF && WS_YF + (size_t)MROWS * WSSM * 4 <= WS_YR && WS_YR + (size_t)MROWS * WSSM * 4 <= WS_YPRE &&
              WS_YPRE + (size_t)MROWS * WSSM * 2 <= WS_END, "d_ws map");
constexpr int CW_QUEUE = 64, CW_BAR = 4096, CW_FLAG = 16384;
constexpr int P0_SIL_OFF = 69632, P0_RED_OFF = 118784, P0_Q_OFF = 131072;
constexpr int SSM_URING_OFF = 133120;
constexpr int LDSCTL_OFF = 143360, MISC_OFF = LDSCTL_OFF + 320;
constexpr int LDS_BYTES = 147456;
namespace pg8 {
#define PG8_LAS __attribute__((address_space(3)))
typedef unsigned short bf16_t;
typedef short bf16x8 __attribute__((ext_vector_type(8)));
typedef float f32x4 __attribute__((ext_vector_type(4)));
typedef unsigned u32x4 __attribute__((ext_vector_type(4)));
constexpr int BM = 256, BK = 64, HALF = 128, HTB = HALF * BK * 2  , STAGE_BYTES = 8 * HTB, NXCD = 8, WGM = 8;

__host__ __device__ __forceinline__ int lds_byte(int r, int c) { const int st = (r >> 4) * 2 + (c >> 5), rr = r & 15, cc = c & 31, ob = rr * 64 + cc * 2; return st * 1024 + (ob ^ (((ob >> 9) & 1) << 5)); }
__host__ __device__ __forceinline__ void stage_rc(int b, int& R, int& C) { const int st = b / 1024, sb = b % 1024, swz = sb ^ (((sb >> 9) & 1) << 5); R = (st >> 1) * 16 + swz / 64; C = (st & 1) * 32 + (swz % 64) / 2; }
__host__ __device__ __forceinline__ int perm32(int rho) { const int n = rho >> 4, i = rho & 15; return 8 * (i >> 2) + 4 * n + (i & 3); }

struct Unit { int pm, pn, k0, nt; };
struct Gemm { const bf16_t* A; const bf16_t* Bt; int M, N, K; };

struct StaticOrder {
    static constexpr bool HANDOFF = false;
    int nM, nN, nwg, G, c;
    __host__ __device__ void init(int M, int N, int G_, int c_) { nM = M / BM; nN = N / BM; nwg = nM * nN; G = G_; c = c_; }
    __host__ __device__ bool next(int i, Unit& u) const {
        const long L = (long)i * G + c; if (L >= nwg) return false;
        int wgid = (int)L; { const int q = nwg / NXCD, r = nwg % NXCD, xcd = wgid % NXCD, off = wgid / NXCD; wgid = (xcd < r ? xcd * (q + 1) : r * (q + 1) + (xcd - r) * q) + off; }
        const int nig = WGM * nN, gid = wgid / nig, fm = gid * WGM, gsz = (nM - fm) < WGM ? (nM - fm) : WGM;
        u.pm = fm + ((wgid % nig) % gsz); u.pn = (wgid % nig) / gsz; u.k0 = 0; u.nt = 0; return true;
    }
    __device__ __forceinline__ void a_ready(const Unit&) const {}
    __device__ __forceinline__ void done(const Unit&) const {}
};

__device__ __forceinline__ unsigned cvt_pk_bf16(float lo, float hi) { unsigned r; asm volatile("v_cvt_pk_bf16_f32 %0, %1, %2" : "=v"(r) : "v"(lo), "v"(hi)); return r; }
typedef float f32x2 __attribute__((ext_vector_type(2)));

struct SplitOrder {
    static constexpr bool HANDOFF = false;
    StaticOrder lat; int nlat_units, nN, nsplit_units, ks_tiles, G, c;
    __host__ __device__ void init(int Mlat, int Mctx, int N, int K, int KS, int G_, int c_) { lat.init(Mlat, N, G_, c_); nlat_units = (Mlat / BM) * (N / BM); nN = N / BM; nsplit_units = (Mctx / BM) * nN * KS; ks_tiles = K / BK / KS; G = G_; c = c_; ksn = KS; mlat_tiles = Mlat / BM; }
    int ksn, mlat_tiles;
    __host__ __device__ bool next(int i, Unit& u) const {
        const long L = (long)i * G + c;
        if (L < nlat_units) return lat.next(i, u);
        const int s = (int)(L - nlat_units); if (s >= nsplit_units) return false;
        const int per_pm = nN * ksn, rem = s % per_pm; u.pm = mlat_tiles + s / per_pm; u.pn = rem / ksn; const int ks = rem % ksn; u.k0 = ks * ks_tiles * BK; u.nt = ks_tiles; return true;
    }
    __device__ __forceinline__ void a_ready(const Unit&) const {}
    __device__ __forceinline__ void done(const Unit&) const {}
};

struct TwoPartOrder {
    static constexpr bool HANDOFF = false;
    StaticOrder lat; int nlat_units, nN, nctx_units, mlat_tiles, G, c, nwg;
    __host__ __device__ void init(int Mlat, int Mctx, int N, int G_, int c_) { lat.init(Mlat, N, G_, c_); nlat_units = (Mlat / BM) * (N / BM); nN = N / BM; nctx_units = (Mctx / BM) * nN; mlat_tiles = Mlat / BM; G = G_; c = c_; nwg = nlat_units + nctx_units; }
    __host__ __device__ bool next(int i, Unit& u) const {
        const long L = (long)i * G + c;
        if (L < nlat_units) return lat.next(i, u);
        const int s = (int)(L - nlat_units); if (s >= nctx_units) return false;
        u.pm = mlat_tiles + s / nN; u.pn = s % nN; u.k0 = 0; u.nt = 0; return true;
    }
    __device__ __forceinline__ void a_ready(const Unit&) const {}
    __device__ __forceinline__ void done(const Unit&) const {}
};

template <int KS, int PER> struct HandoffOrder {
    static constexpr bool HANDOFF = true;
    static constexpr int ks = KS, per = PER;
    StaticOrder lat; int nlat_units, nN, nctx_units, mlat_tiles, G, c, ktiles, flag_word; float* slab;
    __host__ __device__ void init(int Mlat, int Mctx, int N, int K, int G_, int c_, float* slab_, int flag_word_) { lat.init(Mlat, N, G_, c_); nlat_units = (Mlat / BM) * (N / BM); nN = N / BM;
        nctx_units = (Mctx / BM) * nN; mlat_tiles = Mlat / BM; G = G_; c = c_; ktiles = K / BK; slab = slab_; flag_word = flag_word_; }
    __host__ __device__ bool next(int i, Unit& u) const {
        const long L = (long)i * G + c;
        if (L < nlat_units) return lat.next(i, u);
        const int s = (int)(L - nlat_units);
        if (nlat_units % G != 0 || nctx_units * KS > G) { if (s >= nctx_units) return false; u.pm = mlat_tiles + s / nN; u.pn = s % nN; u.k0 = 0; u.nt = 0; return true; }
        if (s >= nctx_units * KS) return false;
        const int sl = (s >= nctx_units ? 1 : 0) + (s >= 2 * nctx_units ? 1 : 0) + (s >= 3 * nctx_units ? 1 : 0), uid = s - sl * nctx_units;
        u.pm = mlat_tiles + uid / nN; u.pn = uid % nN; u.k0 = sl * PER * BK; u.nt = (sl == KS - 1) ? ktiles - (KS - 1) * PER : PER; return true;
    }
    __device__ __forceinline__ int slice_of(const Unit& u) const { return u.k0 / (PER * BK); }
    __device__ __forceinline__ int uid_of(const Unit& u) const { return (u.pm - mlat_tiles) * nN + u.pn; }
    __device__ __forceinline__ unsigned* flag_of(int uid) const { return (unsigned*)((char*)slab - WS_PART + WS_CTL) + flag_word + uid; }
    __device__ __forceinline__ void a_ready(const Unit&) const {}
    __device__ __forceinline__ void done(const Unit&) const {}
};
constexpr int NLAT_ROWS = 16384, DMODEL = 4096, MODW = 36864;
__device__ __forceinline__ int row_set(int pm) { return pm < 32 ? 0 : (pm < 64 ? 1 : 2); }
__device__ __forceinline__ float bf_lo(unsigned w) { return __uint_as_float(w << 16); }
__device__ __forceinline__ float bf_hi(unsigned w) { return __uint_as_float(w & 0xffff0000u); }
__device__ __forceinline__ float sigmoid_f(float a) { return __builtin_amdgcn_rcpf(1.0f + __builtin_amdgcn_exp2f(-1.4426950408889634f * a)); }

struct EpiSwiGLU {
    static constexpr bool PERM = true, AFTER_DRAIN = false;
    bf16_t* O; int ldc;
    __device__ __forceinline__ void operator()(const f32x4 (&acc)[2][2][4][2], const Unit& u, int wr, int wc, int fr, int fq) const {
        const int row0 = u.pm * BM + wr * 64 + fr, col0 = u.pn * HALF + wc * 32 + 8 * fq;
#pragma unroll
        for (int ai = 0; ai < 2; ++ai)
#pragma unroll
            for (int m = 0; m < 4; ++m) { bf16_t* rowp = O + (size_t)(row0 + ai * HALF + m * 16) * ldc + col0;
                float h[8];
#pragma unroll
                for (int n = 0; n < 2; ++n)
#pragma unroll
                    for (int x = 0; x < 4; ++x) { const float a = acc[ai][0][m][n][x], b = acc[ai][1][m][n][x]; h[n * 4 + x] = a * b * sigmoid_f(a); }
                u32x4 w; w.x = cvt_pk_bf16(h[0], h[1]); w.y = cvt_pk_bf16(h[2], h[3]); w.z = cvt_pk_bf16(h[4], h[5]); w.w = cvt_pk_bf16(h[6], h[7]);
                *(u32x4*)rowp = w; }
    }
};
typedef _Float16 f16_t;
typedef _Float16 f16x8 __attribute__((ext_vector_type(8)));
typedef float f32x8 __attribute__((ext_vector_type(8)));
struct EpiResid {
    static constexpr bool PERM = true, AFTER_DRAIN = false;
    const float* base_lat32; const float* base_ctx32;
    f16_t* X; const float* gate; float scale; float* part;
    __device__ __forceinline__ void operator()(const f32x4 (&acc)[2][2][4][2], const Unit& u, int wr, int wc, int fr, int fq) const {
        const int col0 = u.pn * BM + wc * 32 + 8 * fq;
        const unsigned loff = (unsigned)((wr * 64 + fr) * DMODEL + col0);
        if (u.nt != 0) {
            float* pb = part + ((size_t)(u.k0 / (u.nt * BK)) * (2 * BM) + (size_t)(u.pm - 64) * BM) * DMODEL;
#pragma unroll
            for (int ai = 0; ai < 2; ++ai)
#pragma unroll
                for (int m = 0; m < 4; ++m) { float* dst = pb + (loff + (unsigned)((ai * HALF + m * 16) * DMODEL));
#pragma unroll
                    for (int bj = 0; bj < 2; ++bj) { *(f32x4*)(dst + bj * HALF) = acc[ai][bj][m][0]; *(f32x4*)(dst + bj * HALF + 4) = acc[ai][bj][m][1]; }
                    asm volatile("" ::: "memory"); }
            return; }
        const float* g = gate + row_set(u.pm) * MODW + col0;
        f16_t* dbase = X + (size_t)u.pm * BM * DMODEL;
        f32x4 gv[2][2];
#pragma unroll
        for (int bj = 0; bj < 2; ++bj)
#pragma unroll
            for (int n = 0; n < 2; ++n) gv[bj][n] = *(const f32x4*)(g + bj * HALF + 4 * n) * scale;
        if (base_lat32 != nullptr) {
            const float* sbase = (u.pm < 64) ? base_lat32 + (size_t)u.pm * BM * DMODEL : base_ctx32 + (size_t)(u.pm - 64) * BM * DMODEL;
#pragma unroll
            for (int ai = 0; ai < 2; ++ai)
#pragma unroll
              for (int m = 0; m < 4; ++m) { const unsigned o1 = loff + (unsigned)((ai * HALF + m * 16) * DMODEL);
                f32x4 bv[2][2];
#pragma unroll
                for (int bj = 0; bj < 2; ++bj)
#pragma unroll
                    for (int n = 0; n < 2; ++n) bv[bj][n] = *(const f32x4*)(sbase + o1 + bj * HALF + 4 * n);
#pragma unroll
                for (int bj = 0; bj < 2; ++bj) { const f32x4 r0 = bv[bj][0] + gv[bj][0] * acc[ai][bj][m][0], r1 = bv[bj][1] + gv[bj][1] * acc[ai][bj][m][1];
                    const f32x8 r = {r0[0], r0[1], r0[2], r0[3], r1[0], r1[1], r1[2], r1[3]}; *(f16x8*)(dbase + o1 + bj * HALF) = __builtin_convertvector(r, f16x8); }
                asm volatile("" ::: "memory"); }
        } else {
#pragma unroll
            for (int ai = 0; ai < 2; ++ai) {
                f16x8 bv[4][2];
#pragma unroll
                for (int m = 0; m < 4; ++m)
#pragma unroll
                    for (int bj = 0; bj < 2; ++bj) bv[m][bj] = *(const f16x8*)(dbase + (loff + (unsigned)((ai * HALF + m * 16) * DMODEL)) + bj * HALF);
#pragma unroll
                for (int m = 0; m < 4; ++m)
#pragma unroll
                    for (int bj = 0; bj < 2; ++bj) { const f32x8 b = __builtin_convertvector(bv[m][bj], f32x8);
                        const f32x4 a0 = acc[ai][bj][m][0], a1 = acc[ai][bj][m][1], g0 = gv[bj][0], g1 = gv[bj][1];
                        const f32x8 r = {b[0] + g0[0] * a0[0], b[1] + g0[1] * a0[1], b[2] + g0[2] * a0[2], b[3] + g0[3] * a0[3], b[4] + g1[0] * a1[0], b[5] + g1[1] * a1[1], b[6] + g1[2] * a1[2], b[7] + g1[3] * a1[3]};
                        *(f16x8*)(dbase + (loff + (unsigned)((ai * HALF + m * 16) * DMODEL)) + bj * HALF) = __builtin_convertvector(r, f16x8); }
                asm volatile("" ::: "memory"); }
        }
    }
};
struct EpiRope {
    static constexpr bool PERM = true, AFTER_DRAIN = false;
    bf16_t* O; int ldc; const float* tab;
    __device__ __forceinline__ void operator()(const f32x4 (&acc)[2][2][4][2], const Unit& u, int wr, int wc, int fr, int fq) const {
        const bool rope = (u.pn >= 12 && u.pn < 28 && u.pm < 64);
        const float qs = (u.pn >= 12 && u.pn < 20) ? 0.18033688011112042f : 1.0f;
        const int col0 = u.pn * BM + wc * 32 + 8 * fq;
        const bool first = fq < 2;
#pragma unroll
        for (int ai = 0; ai < 2; ++ai)
#pragma unroll
            for (int m = 0; m < 4; ++m) { const int row = u.pm * BM + ai * HALF + wr * 64 + m * 16 + fr; bf16_t* rowp = O + (size_t)row * ldc + col0;
                if (rope) { const int t = row & 8191, pos = (wc & 1) ? (t & 63) : (t >> 6); const float* tp = tab + pos * 32 + 8 * (fq & 1);
                    const f32x4 cs0 = *(const f32x4*)tp, cs1 = *(const f32x4*)(tp + 4), sn0 = *(const f32x4*)(tp + 16), sn1 = *(const f32x4*)(tp + 20);
#pragma unroll
                    for (int bj = 0; bj < 2; ++bj) { float o[8];
#pragma unroll
                        for (int n = 0; n < 2; ++n)
#pragma unroll
                            for (int x = 0; x < 4; ++x) { const float v = acc[ai][bj][m][n][x];
                                const auto rr = __builtin_amdgcn_permlane32_swap(__float_as_uint(v), __float_as_uint(v), false, false);
                                const float p = __uint_as_float(first ? rr[1] : rr[0]);
                                const float c = n ? cs1[x] : cs0[x], s = n ? sn1[x] : sn0[x];
                                o[4 * n + x] = (first ? v * c - p * s : v * c + p * s) * qs; }
                        u32x4 w; w.x = cvt_pk_bf16(o[0], o[1]); w.y = cvt_pk_bf16(o[2], o[3]); w.z = cvt_pk_bf16(o[4], o[5]); w.w = cvt_pk_bf16(o[6], o[7]);
                        *(u32x4*)(rowp + bj * HALF) = w; }
                } else {
#pragma unroll
                    for (int bj = 0; bj < 2; ++bj) { const f32x4 v0 = acc[ai][bj][m][0] * qs, v1 = acc[ai][bj][m][1] * qs;
                        u32x4 w; w.x = cvt_pk_bf16(v0[0], v0[1]); w.y = cvt_pk_bf16(v0[2], v0[3]); w.z = cvt_pk_bf16(v1[0], v1[1]); w.w = cvt_pk_bf16(v1[2], v1[3]);
                        *(u32x4*)(rowp + bj * HALF) = w; } }
            }
    }
};
struct EpiGlu {
    static constexpr bool PERM = true, AFTER_DRAIN = false;
    const bf16_t* Y; int ldy; bf16_t* O; int ldc; int ocol0;
    __device__ __forceinline__ void operator()(const f32x4 (&acc)[2][2][4][2], const Unit& u, int wr, int wc, int fr, int fq) const {
        const int row0 = u.pm * BM + wr * 64 + fr, col0 = u.pn * BM + wc * 32 + 8 * fq;
#pragma unroll
        for (int ai = 0; ai < 2; ++ai)
#pragma unroll
            for (int m = 0; m < 4; ++m) { const size_t row = (size_t)(row0 + ai * HALF + m * 16);
#pragma unroll
                for (int bj = 0; bj < 2; ++bj) { const int c = col0 + bj * HALF; const u32x4 yv = *(const u32x4*)(Y + row * ldy + c);
                    const f32x4 v0 = acc[ai][bj][m][0], v1 = acc[ai][bj][m][1];
                    u32x4 w; w.x = cvt_pk_bf16(bf_lo(yv.x) * sigmoid_f(v0[0]), bf_hi(yv.x) * sigmoid_f(v0[1])); w.y = cvt_pk_bf16(bf_lo(yv.y) * sigmoid_f(v0[2]), bf_hi(yv.y) * sigmoid_f(v0[3]));
                    w.z = cvt_pk_bf16(bf_lo(yv.z) * sigmoid_f(v1[0]), bf_hi(yv.z) * sigmoid_f(v1[1])); w.w = cvt_pk_bf16(bf_lo(yv.w) * sigmoid_f(v1[2]), bf_hi(yv.w) * sigmoid_f(v1[3]));
                    *(u32x4*)(O + row * ldc + ocol0 + c) = w; } }
    }
};

struct EpiNull {
    static constexpr bool PERM = false, AFTER_DRAIN = false;
    float* O;
    __device__ __forceinline__ void operator()(const f32x4 (&acc)[2][2][4][2], const Unit& u, int wr, int wc, int fr, int fq) const {
        f32x4 s = {0.f, 0.f, 0.f, 0.f};
#pragma unroll
        for (int ai = 0; ai < 2; ++ai)
#pragma unroll
            for (int bj = 0; bj < 2; ++bj)
#pragma unroll
                for (int m = 0; m < 4; ++m)
#pragma unroll
                    for (int n = 0; n < 2; ++n) s += acc[ai][bj][m][n];
        *(f32x4*)(O + ((size_t)(u.pm * 16 + u.pn) * 512 + (wr * 4 + wc) * 64 + fq * 16 + fr) * 4) = s;
    }
};
template <class Epi, class Sched, bool ALIGN_EPI = false, bool SP2 = false>
__device__ __forceinline__ void gemm_phase(PG8_LAS unsigned char* lds, const Gemm g, const Sched& S, const Epi& E) {
    int tid_ = threadIdx.x; asm volatile("" : "+v"(tid_));
    const int tid = tid_, wid = __builtin_amdgcn_readfirstlane(tid >> 6), lane = tid & 63, wr = wid >> 2, wc = wid & 3, fr = lane & 15, fq = lane >> 4;
    const int K = g.K, nt = K / BK;
    unsigned voffA[2], voffB[2];
#pragma unroll
    for (int i = 0; i < 2; ++i) { int R, C; stage_rc(tid * 16 + i * 8192, R, C); const int Rb = Epi::PERM ? ((R & ~31) + perm32(R & 31)) : R;
        voffA[i] = (unsigned)(R * K + C) * 2u; voffB[i] = (unsigned)(Rb * K + C) * 2u; }
    const size_t kstep = (size_t)(BK * 2);
    const size_t hstep = (size_t)HALF * K * 2;
    const size_t tstep = 2 * hstep;
    const unsigned ldsu = (unsigned)(uintptr_t)lds;
    const unsigned ldsw = (unsigned)wid * 1024u;
    const int aoff = lds_byte(wr * 64 + fr, fq * 8), boff = lds_byte(wc * 32 + fr, fq * 8);
#define PG8_SA(b, h) (((b) * 2 + (h)) * HTB)
#define PG8_SB(b, h) ((4 + (b) * 2 + (h)) * HTB)
#define PG8_STAGE(bufoff, gbase, voff) do {     \
        asm volatile("s_mov_b32 m0, %3\n\ts_nop 0\n\tglobal_load_lds_dwordx4 %0, %2\n\ts_mov_b32 m0, %4\n\ts_nop 0\n\tglobal_load_lds_dwordx4 %1, %2" \
            :: "v"((voff)[0]), "v"((voff)[1]), "s"((const char*)(gbase)), "s"(ldsu + (unsigned)(bufoff) + ldsw), "s"(ldsu + (unsigned)(bufoff) + ldsw + 8192u) : "memory"); } while (0)
#define PG8_LDA(dst, b, h) do { _Pragma("unroll") for (int m = 0; m < 4; ++m) _Pragma("unroll") for (int k = 0; k < 2; ++k) dst[m][k] = *(const PG8_LAS bf16x8*)(lds + PG8_SA(b, h) + aoff + m * 2048 + k * 1024); } while (0)
#define PG8_LDB(dst, b, h) do { _Pragma("unroll") for (int n = 0; n < 2; ++n) _Pragma("unroll") for (int k = 0; k < 2; ++k) dst[n][k] = *(const PG8_LAS bf16x8*)(lds + PG8_SB(b, h) + boff + n * 2048 + k * 1024); } while (0)
#define PG8_MMA(ai, bj, At, Bt) do { _Pragma("unroll") for (int m = 0; m < 4; ++m) _Pragma("unroll") for (int n = 0; n < 2; ++n) _Pragma("unroll") for (int k = 0; k < 2; ++k) \
        acc[ai][bj][m][n] = __builtin_amdgcn_mfma_f32_16x16x32_bf16(Bt[n][k], At[m][k], acc[ai][bj][m][n], 0, 0, 0); } while (0)
#define PG8_MMAP(ai, bj, At, Bt) do { __builtin_amdgcn_s_setprio(1); PG8_MMA(ai, bj, At, Bt); __builtin_amdgcn_s_setprio(0); } while (0)
#define PG8_WAIT_V(n) asm volatile("s_waitcnt vmcnt(" #n ")" ::: "memory")
#define PG8_WAIT_L(n) asm volatile("s_waitcnt lgkmcnt(" #n ")" ::: "memory")
#define PG8_WAIT_L0 do { __builtin_amdgcn_s_waitcnt(0xC07F); asm volatile("" ::: "memory"); } while (0)
#define PG8_BAR __builtin_amdgcn_s_barrier()
#define PG8_SCHED __builtin_amdgcn_sched_barrier(0)
    Unit cur, nxt; int ui = 0;
    if (!S.next(0, cur)) return;
    f32x4 acc[2][2][4][2];
#pragma unroll
    for (int a = 0; a < 2; ++a)
#pragma unroll
        for (int b = 0; b < 2; ++b)
#pragma unroll
            for (int m = 0; m < 4; ++m)
#pragma unroll
                for (int n = 0; n < 2; ++n) acc[a][b][m][n] = (f32x4){0.f, 0.f, 0.f, 0.f};
    bf16x8 At[4][2], B0[2][2], B1[2][2];
    const char* cA = (const char*)g.A + (size_t)cur.pm * tstep + (size_t)cur.k0 * 2; const char* cB = (const char*)g.Bt + (size_t)cur.pn * tstep + (size_t)cur.k0 * 2;
    S.a_ready(cur);
    if constexpr (SP2) {
        PG8_STAGE(PG8_SB(0, 0), cB, voffB); PG8_STAGE(PG8_SB(0, 1), cB + hstep, voffB); PG8_STAGE(PG8_SA(0, 0), cA, voffA); PG8_STAGE(PG8_SA(0, 1), cA + hstep, voffA);
        if (wr == 1) PG8_BAR;
        PG8_WAIT_V(2); PG8_BAR;
        PG8_STAGE(PG8_SB(1, 0), cB + kstep, voffB); PG8_STAGE(PG8_SA(1, 0), cA + kstep, voffA); PG8_STAGE(PG8_SB(1, 1), cB + hstep + kstep, voffB);
        PG8_WAIT_V(6); PG8_BAR;
    } else {
        PG8_STAGE(PG8_SB(0, 0), cB, voffB); PG8_STAGE(PG8_SA(0, 0), cA, voffA); PG8_STAGE(PG8_SB(0, 1), cB + hstep, voffB); PG8_STAGE(PG8_SA(0, 1), cA + hstep, voffA);
        if (wr == 1) PG8_BAR;
        PG8_WAIT_V(4); PG8_BAR;
        PG8_STAGE(PG8_SB(1, 0), cB + kstep, voffB); PG8_STAGE(PG8_SA(1, 0), cA + kstep, voffA); PG8_STAGE(PG8_SB(1, 1), cB + hstep + kstep, voffB);
        PG8_WAIT_V(6); PG8_BAR;
    }
    for (;;) {
        const bool has_next = S.next(ui + 1, nxt);
        const char* nA = has_next ? (const char*)g.A + (size_t)nxt.pm * tstep + (size_t)nxt.k0 * 2 : cA; const char* nB = has_next ? (const char*)g.Bt + (size_t)nxt.pn * tstep + (size_t)nxt.k0 * 2 : cB;
        const int cnt = cur.nt ? cur.nt : nt;
        for (int t = 0; t < cnt; t += 2) {
            const bool last = (t == cnt - 2);
            const char* a1 = cA + (size_t)(t + 1) * kstep;
            const char* a2 = last ? nA : cA + (size_t)(t + 2) * kstep; const char* b2 = last ? nB : cB + (size_t)(t + 2) * kstep;
            const char* a3 = a2 + kstep; const char* b3 = b2 + kstep;
            if (last && has_next) S.a_ready(nxt);
            if constexpr (SP2) {
            PG8_LDB(B0, 0, 0); PG8_LDB(B1, 0, 1); PG8_SCHED; PG8_LDA(At, 0, 0); PG8_STAGE(PG8_SA(1, 1), a1 + hstep, voffA);
            PG8_WAIT_V(8); PG8_WAIT_L0; __builtin_amdgcn_s_setprio(1); PG8_BAR; PG8_MMA(0, 0, At, B0); PG8_MMA(0, 1, At, B1); __builtin_amdgcn_s_setprio(0); PG8_BAR; PG8_SCHED;
            PG8_LDA(At, 0, 1); PG8_STAGE(PG8_SB(0, 0), b2, voffB); PG8_STAGE(PG8_SB(0, 1), b2 + hstep, voffB); PG8_STAGE(PG8_SA(0, 0), a2, voffA);
            PG8_WAIT_V(8); PG8_WAIT_L0; __builtin_amdgcn_s_setprio(1); PG8_BAR; PG8_MMA(1, 0, At, B0); PG8_MMA(1, 1, At, B1); __builtin_amdgcn_s_setprio(0); PG8_BAR; PG8_SCHED;
            PG8_LDB(B0, 1, 0); PG8_LDB(B1, 1, 1); PG8_SCHED; PG8_LDA(At, 1, 0); PG8_STAGE(PG8_SA(0, 1), a2 + hstep, voffA);
            PG8_WAIT_V(8); PG8_WAIT_L0; __builtin_amdgcn_s_setprio(1); PG8_BAR; PG8_MMA(0, 0, At, B0); PG8_MMA(0, 1, At, B1); __builtin_amdgcn_s_setprio(0); PG8_BAR; PG8_SCHED;
            PG8_LDA(At, 1, 1); PG8_STAGE(PG8_SB(1, 0), b3, voffB); PG8_STAGE(PG8_SB(1, 1), b3 + hstep, voffB); PG8_STAGE(PG8_SA(1, 0), a3, voffA);
            PG8_WAIT_V(8); PG8_WAIT_L0; __builtin_amdgcn_s_setprio(1); PG8_BAR; PG8_MMA(1, 0, At, B0); PG8_MMA(1, 1, At, B1); __builtin_amdgcn_s_setprio(0); PG8_BAR; PG8_SCHED;
            } else {
            PG8_LDB(B0, 0, 0); PG8_SCHED; PG8_LDA(At, 0, 0); PG8_STAGE(PG8_SA(1, 1), a1 + hstep, voffA);
            PG8_WAIT_L(8); PG8_BAR; PG8_WAIT_L(0); PG8_MMAP(0, 0, At, B0); PG8_BAR; PG8_SCHED;
            PG8_LDB(B1, 0, 1); PG8_STAGE(PG8_SB(0, 0), b2, voffB);
            PG8_BAR; PG8_WAIT_L(0); PG8_MMAP(0, 1, At, B1); PG8_BAR;
            PG8_LDA(At, 0, 1); PG8_STAGE(PG8_SA(0, 0), a2, voffA);
            PG8_BAR; PG8_WAIT_L(0); PG8_MMAP(1, 0, At, B0); PG8_BAR; PG8_SCHED;
            PG8_STAGE(PG8_SB(0, 1), b2 + hstep, voffB);
            PG8_WAIT_V(6); PG8_BAR; PG8_MMAP(1, 1, At, B1); PG8_BAR;
            PG8_LDB(B0, 1, 0); PG8_SCHED; PG8_LDA(At, 1, 0); PG8_STAGE(PG8_SA(0, 1), a2 + hstep, voffA);
            PG8_WAIT_L(8); PG8_BAR; PG8_WAIT_L(0); PG8_MMAP(0, 0, At, B0); PG8_BAR; PG8_SCHED;
            PG8_LDB(B1, 1, 1); PG8_STAGE(PG8_SB(1, 0), b3, voffB);
            PG8_BAR; PG8_WAIT_L(0); PG8_MMAP(0, 1, At, B1); PG8_BAR;
            PG8_LDA(At, 1, 1); PG8_STAGE(PG8_SA(1, 0), a3, voffA);
            PG8_BAR; PG8_WAIT_L(0); PG8_MMAP(1, 0, At, B0); PG8_BAR; PG8_SCHED;
            PG8_STAGE(PG8_SB(1, 1), b3 + hstep, voffB);
            PG8_WAIT_V(6); PG8_BAR; PG8_MMAP(1, 1, At, B1); PG8_BAR;
            }
        }
        if constexpr (ALIGN_EPI) { if (wr == 0) PG8_BAR; }
        if constexpr (Sched::HANDOFF) {
            if (cur.nt != 0) {
                typedef __attribute__((address_space(1))) unsigned g_u32; typedef __attribute__((address_space(1))) f32x4 g_f32x4;
                const int sl = S.slice_of(cur), uid = S.uid_of(cur);
                const int tid2 = wid * 64 + fq * 16 + fr;
                const unsigned voff_ = (unsigned)tid2 * 16u;
                const char* ub = (const char*)(S.slab + (size_t)uid * (size_t)(S.ks - 1) * 65536u);
                g_u32* fl = (g_u32*)S.flag_of(uid);
                if (sl < S.ks - 1) {
                    const char* pb_ = ub + (size_t)sl * 262144u;
#pragma unroll
                    for (int a = 0; a < 2; ++a)
#pragma unroll
                        for (int b = 0; b < 2; ++b)
#pragma unroll
                            for (int m = 0; m < 4; ++m)
#pragma unroll
                                for (int n = 0; n < 2; ++n)
#ifndef HO_NOSTORE
 asm volatile("global_store_dwordx4 %0, %1, %2 sc1" :: "v"(voff_), "v"(acc[a][b][m][n]), "s"(pb_ + (((a * 2 + b) * 4 + m) * 2 + n) * 8192) : "memory");
#else
 ;
#endif
                    asm volatile("s_waitcnt vmcnt(0)" ::: "memory");
                    __syncthreads();
                    if (tid2 == 0) __hip_atomic_fetch_add(fl, 1u, __ATOMIC_RELAXED, __HIP_MEMORY_SCOPE_AGENT);
                    break;
                } else {
                    if (wid == 0) {
                        if ((fq | fr) == 0) { unsigned spins = 0; while (__hip_atomic_load(fl, __ATOMIC_RELAXED, __HIP_MEMORY_SCOPE_AGENT) < (unsigned)(S.ks - 1) && ++spins < (1u << 16)) __builtin_amdgcn_s_sleep(4); }
                        __builtin_amdgcn_fence(__ATOMIC_ACQUIRE, "agent"); }
                    asm volatile("s_waitcnt vmcnt(0)" ::: "memory");
                    __syncthreads();
                    for (int s_ = 0; s_ < S.ks - 1; ++s_) { const char* qb_ = ub + (size_t)s_ * 262144u;
#pragma unroll
                        for (int a = 0; a < 2; ++a) { f32x4 t_[16];
#pragma unroll
                            for (int i = 0; i < 16; ++i) asm volatile("global_load_dwordx4 %0, %1, %2" : "=v"(t_[i]) : "v"(voff_), "s"(qb_ + (a * 16 + i) * 8192) : "memory");
                            asm volatile("s_waitcnt vmcnt(0)" : "+v"(t_[0]), "+v"(t_[1]), "+v"(t_[2]), "+v"(t_[3]), "+v"(t_[4]), "+v"(t_[5]), "+v"(t_[6]), "+v"(t_[7]),
                                         "+v"(t_[8]), "+v"(t_[9]), "+v"(t_[10]), "+v"(t_[11]), "+v"(t_[12]), "+v"(t_[13]), "+v"(t_[14]), "+v"(t_[15]) :: "memory");
#pragma unroll
                            for (int i = 0; i < 16; ++i) acc[a][i >> 3][(i >> 1) & 3][i & 1] += t_[i]; }
                    }
                }
            }
        }
        if constexpr (!Epi::AFTER_DRAIN) { E(acc, cur, wr, wc, fr, fq); S.done(cur); }
        if (!has_next) break;
#pragma unroll
        for (int a = 0; a < 2; ++a)
#pragma unroll
            for (int b = 0; b < 2; ++b)
#pragma unroll
                for (int m = 0; m < 4; ++m)
#pragma unroll
                    for (int n = 0; n < 2; ++n) acc[a][b][m][n] = (f32x4){0.f, 0.f, 0.f, 0.f};
        cur = nxt; cA = nA; cB = nB; ++ui;
        if constexpr (ALIGN_EPI) { if (wr == 1) PG8_BAR; }
    }
    PG8_WAIT_V(0);
    if constexpr (!ALIGN_EPI) { if (wr == 0) PG8_BAR; }
    PG8_BAR;
    if constexpr (Epi::AFTER_DRAIN) { E.fused(acc, cur, wr, wc, fr, fq, lds, wid, lane); S.done(cur); }
#undef PG8_SA
#undef PG8_SB
#undef PG8_STAGE
#undef PG8_LDA
#undef PG8_LDB
#undef PG8_MMA
#undef PG8_MMAP
#undef PG8_WAIT_L0
#undef PG8_WAIT_V
#undef PG8_WAIT_L
#undef PG8_BAR
#undef PG8_SCHED
}
}
namespace att {
using bf16x8 = __attribute__((ext_vector_type(8))) short;
using s16x4  = __attribute__((ext_vector_type(4))) short;
using f32x16 = __attribute__((ext_vector_type(16))) float;
using u32x4  = __attribute__((ext_vector_type(4))) unsigned;
typedef unsigned short bf16_t;
constexpr int NW = 8, QBLK = 32, KVBLK = 64, LDP = 10240, LDY = 4096;
constexpr int OFF_Q = 3072, OFF_K = 5120, OFF_V = 7168, YC_ATT = 1024;
constexpr float SCALE = 0.125f, THR = 8.f;
constexpr int SHM_V = KVBLK * 128 * 2, SHM_K = KVBLK * 128 * 2, SHM_ATTN = 2 * SHM_V + 2 * SHM_K + NW * 64 * 4;
#define KSWZ(row, colB) ((row) * 256 + ((colB) ^ (((row) & 7) << 4)))
#define SBAR() __builtin_amdgcn_sched_barrier(0)
__device__ __forceinline__ int crow(int r, int hi) { return (r & 3) + 8 * (r >> 2) + 4 * hi; }
__device__ __forceinline__ unsigned cvtpk(float lo, float hi) { unsigned r; asm volatile("v_cvt_pk_bf16_f32 %0, %1, %2" : "=v"(r) : "v"(lo), "v"(hi)); return r; }
__device__ __forceinline__ bf16x8 ld8(const bf16_t* p) { return *reinterpret_cast<const bf16x8*>(p); }

__device__ __forceinline__ void partialSM(f32x16& p0, f32x16& p1, float& m_reg, float& mn, float& alpha) {
  constexpr float C = SCALE * 1.4426950408889634f;
  float pmax = p0[0];
#pragma unroll
  for (int r = 1; r < 16; ++r) pmax = fmaxf(pmax, p0[r]);
#pragma unroll
  for (int r = 0; r < 16; ++r) pmax = fmaxf(pmax, p1[r]);
  { auto rr = __builtin_amdgcn_permlane32_swap(__float_as_uint(pmax), __float_as_uint(pmax), false, false);
    pmax = fmaxf(__uint_as_float(rr[0]), __uint_as_float(rr[1])); }
  if (__builtin_expect(__all(pmax - m_reg <= THR / SCALE), 1)) { mn = m_reg; alpha = 1.f; }
  else { mn = fmaxf(m_reg, pmax); alpha = __builtin_amdgcn_exp2f((m_reg - mn) * C); m_reg = mn; }
  float mnC = -mn * C;
#pragma unroll
  for (int r = 0; r < 16; ++r) p0[r] = fmaf(p0[r], C, mnC);
#pragma unroll
  for (int r = 0; r < 16; ++r) p1[r] = fmaf(p1[r], C, mnC);
#pragma unroll
  for (int r = 0; r < 16; ++r) p0[r] = __builtin_amdgcn_exp2f(p0[r]);
}
__device__ __forceinline__ void finishSM(f32x16& p0, f32x16& p1, float alpha, float& l_reg, bf16x8& pa0, bf16x8& pa1, bf16x8& pa2, bf16x8& pa3) {
#pragma unroll
  for (int r = 0; r < 16; ++r) p1[r] = __builtin_amdgcn_exp2f(p1[r]);
  float ps = 0;
#pragma unroll
  for (int r = 0; r < 16; ++r) ps += p0[r];
#pragma unroll
  for (int r = 0; r < 16; ++r) ps += p1[r];
  { auto rr = __builtin_amdgcn_permlane32_swap(__float_as_uint(ps), __float_as_uint(ps), false, false);
    ps = __uint_as_float(rr[0]) + __uint_as_float(rr[1]); }
  l_reg = l_reg * alpha + ps;
#define PK4(P, BASE, OUT) do { u32x4 w = {cvtpk(P[BASE + 0], P[BASE + 1]), cvtpk(P[BASE + 2], P[BASE + 3]), cvtpk(P[BASE + 4], P[BASE + 5]), cvtpk(P[BASE + 6], P[BASE + 7])}; OUT = *reinterpret_cast<bf16x8*>(&w); } while (0)
  PK4(p0, 0, pa0); PK4(p0, 8, pa1); PK4(p1, 0, pa2); PK4(p1, 8, pa3);
#undef PK4
}
__device__ __forceinline__ void qkt(f32x16& p0, f32x16& p1, const char* Ks, const bf16x8* qr, int r32, int hi, int colB0) {
  p0 = f32x16{}; p1 = f32x16{};
#pragma unroll
  for (int d0 = 0; d0 < 4; ++d0) { int cb = colB0 + (d0 * 16 + hi * 8) * 2;
    bf16x8 b0 = *reinterpret_cast<const bf16x8*>(Ks + KSWZ(r32, cb));
    bf16x8 b1 = *reinterpret_cast<const bf16x8*>(Ks + KSWZ(32 + r32, cb));
    p0 = __builtin_amdgcn_mfma_f32_32x32x16_bf16(b0, qr[d0], p0, 0, 0, 0);
    p1 = __builtin_amdgcn_mfma_f32_32x32x16_bf16(b1, qr[d0], p1, 0, 0, 0); }
}
__device__ __forceinline__ int v_st(int k, int c) { const int kk = (k & ~0xC) | ((k & 4) << 1) | ((k & 8) >> 1); return ((kk >> 3) * 4 + (c >> 5)) * 512 + ((kk & 7) * 32 + (c & 31)) * 2; }
__device__ __forceinline__ int v_rd_base(int lane) { return ((lane & 3) << 3) | (((lane >> 2) & 3) << 6) | (((lane >> 4) & 1) << 5) | (((lane >> 5) & 1) << 11); }
constexpr int v_rd_off(int d0, int ks, int half) { return d0 * 512 + ks * 4096 + half * 256; }
template <int OFF> __device__ __forceinline__ s16x4 tr_read(int vb) {
  s16x4 r; asm volatile("ds_read_b64_tr_b16 %0, %1 offset:%2" : "=&v"(r) : "v"(vb), "i"(OFF) : "memory"); return r;
}
typedef short v4i16_t __attribute__((ext_vector_type(4)));
typedef __attribute__((address_space(3))) v4i16_t* lds_v4i16_p;
__device__ __forceinline__ s16x4 vtr(int addr) { return __builtin_bit_cast(s16x4, __builtin_amdgcn_ds_read_tr16_b64_v4i16((lds_v4i16_p)(uintptr_t)(unsigned)addr)); }
__device__ __forceinline__ void pv_all(f32x16* o, int vb, bf16x8 pa0, bf16x8 pa1, bf16x8 pa2, bf16x8 pa3) {
#define PK(L, H) (bf16x8){L[0], L[1], L[2], L[3], H[0], H[1], H[2], H[3]}
#define PVKS(KS, PA) do { _Pragma("unroll") for (int d0 = 0; d0 < 4; ++d0) { const s16x4 l_ = vtr(vb + v_rd_off(d0, KS, 0)), h_ = vtr(vb + v_rd_off(d0, KS, 1)); \
    o[d0] = __builtin_amdgcn_mfma_f32_32x32x16_bf16(PA, PK(l_, h_), o[d0], 0, 0, 0); } } while (0)
  PVKS(0, pa0); PVKS(1, pa1); PVKS(2, pa2); PVKS(3, pa3);
#undef PVKS
#undef PK
}
__device__ __forceinline__ void qkt_c(f32x16& p0, f32x16& p1, const char* Ks, const bf16x8* qr, int r32, int hi, int colB0, const f32x16& cin) {
#pragma unroll
  for (int d0 = 0; d0 < 4; ++d0) { int cb = colB0 + (d0 * 16 + hi * 8) * 2;
    bf16x8 b0 = *reinterpret_cast<const bf16x8*>(Ks + KSWZ(r32, cb));
    bf16x8 b1 = *reinterpret_cast<const bf16x8*>(Ks + KSWZ(32 + r32, cb));
    p0 = __builtin_amdgcn_mfma_f32_32x32x16_bf16(b0, qr[d0], d0 == 0 ? cin : p0, 0, 0, 0);
    p1 = __builtin_amdgcn_mfma_f32_32x32x16_bf16(b1, qr[d0], d0 == 0 ? cin : p1, 0, 0, 0); }
}

struct AttnArgs { const bf16_t* P; bf16_t* YC; const float* subg; float lam, oscale; };
#ifndef THRL_VALUE
#define THRL_VALUE 8.f
#endif
constexpr int KRING = 0, VRING = 4 * SHM_K, LDS_WS_OFF = VRING + 4 * SHM_V;
constexpr float THRL = THRL_VALUE;
__device__ __forceinline__ void glds16(const void* gsrc, unsigned lds_dst) { unsigned keep;
  asm volatile("s_mov_b32 %0, m0\n\ts_mov_b32 m0, %2\n\ts_nop 0\n\tglobal_load_lds_dwordx4 %1, off\n\ts_mov_b32 m0, %0" : "=&s"(keep) : "v"(gsrc), "s"(lds_dst) : "memory"); }
__device__ __forceinline__ void glds16s(const void* sbase, unsigned voff, unsigned lds_dst) { unsigned keep = 0;
  asm volatile("s_mov_b32 m0, %2\n\ts_nop 0\n\tglobal_load_lds_dwordx4 %0, %1" :: "v"(voff), "s"(sbase), "s"(lds_dst) : "memory"); (void)keep; }
#define BAR_L() asm volatile("s_waitcnt lgkmcnt(0)\n\ts_barrier" ::: "memory")
#define BAR_VL8() asm volatile("s_waitcnt vmcnt(8) lgkmcnt(0)\n\ts_barrier" ::: "memory")
__device__ __forceinline__ void attn_unit(const AttnArgs& A, int qrow0, int h, int krow_a, int nt_a, int krow_b, int NT, char* lds) {
  int tid_ = threadIdx.x; asm volatile("" : "+v"(tid_));
  const int tid = tid_, wid = __builtin_amdgcn_readfirstlane(tid >> 6), lane = tid & 63, r32 = lane & 31, hi = lane >> 5;
  const int js = wid >> 2, qw = wid & 3;
  const unsigned lds0 = (unsigned)(uintptr_t)lds;
  float* ws = (float*)(lds + LDS_WS_OFF) + wid * 64; float* li_l = ws; float* al_l = ws + 32;
  float m_reg = 0.f, l_reg = 0.f; f32x16 o[4] = {}; f32x16 negm = {}; bf16x8 qr[4];
  const bf16_t* Qw = A.P + (size_t)(qrow0 + qw * QBLK + r32) * LDP + OFF_Q + h * 128 + js * 64 + hi * 8;
  const bf16_t* Kh = A.P + OFF_K + h * 128; const bf16_t* Vh = A.P + OFF_V + h * 128;
  int koff[2], voff[2];
#pragma unroll
  for (int i = 0; i < 2; ++i) { const int c = wid * 2 + i;
    { const int row = 4 * c + (lane >> 4), p = lane & 15; koff[i] = (row * LDP + 8 * (p ^ (row & 7))) * 2; }
    { const int U = c * 64 + lane, S = U >> 5, kk = (S >> 2) * 8 + ((U & 31) >> 2), k = (kk & ~0xC) | ((kk & 4) << 1) | ((kk & 8) >> 1); voff[i] = (k * LDP + (S & 3) * 32 + (U & 3) * 8) * 2; } }
  const int vb0 = (int)lds0 + VRING + v_rd_base(lane);
  const int colB0 = js * 128;
#define TROW(t) ((t) < nt_a ? krow_a + (t) * KVBLK : krow_b + ((t) - nt_a) * KVBLK)
#define ISSUE1(tk, tv, PI) do { const int tk_ = (tk) < NT ? (tk) : NT - 1, tv_ = (tv) < 0 ? 0 : ((tv) < NT ? (tv) : NT - 1); \
    if ((PI) < 2) glds16s((const char*)Kh + (size_t)(TROW(tk_)) * (LDP * 2), (unsigned)koff[(PI) & 1], (unsigned)__builtin_amdgcn_readfirstlane(lds0 + KRING + ((tk) & 3) * SHM_K + wid * 2048 + ((PI) & 1) * 1024)); \
    else glds16s((const char*)Vh + (size_t)(TROW(tv_)) * (LDP * 2), (unsigned)voff[(PI) & 1], (unsigned)__builtin_amdgcn_readfirstlane(lds0 + VRING + ((tv) & 3) * SHM_V + wid * 2048 + ((PI) & 1) * 1024)); } while (0)
#define ISSUE(tk, tv) do { ISSUE1(tk, tv, 0); ISSUE1(tk, tv, 1); ISSUE1(tk, tv, 2); ISSUE1(tk, tv, 3); } while (0)
  bf16x8 pa0 = {}, pa1 = {}, pa2 = {}, pa3 = {};
  ISSUE(0, -1); ISSUE(1, 0); ISSUE(2, 1);
#pragma unroll
  for (int d0 = 0; d0 < 4; ++d0) qr[d0] = ld8(Qw + d0 * 16);
#pragma unroll
  for (int d0 = 0; d0 < 4; ++d0) asm volatile("" : "+v"(qr[d0]));
  asm volatile("s_waitcnt vmcnt(0)" ::: "memory");
  BAR_L();
  s16x4 va[8], vbq[8];
#pragma unroll
  for (int q = 0; q < 8; ++q) { va[q] = s16x4{}; vbq[q] = s16x4{}; }
  for (int j = 0; j < NT; ++j) {
    f32x16 p0, p1;
    {
      const char* Ks = lds + KRING + (j & 3) * SHM_K; const int vb = vb0 + ((j - 1) & 3) * SHM_V;
      bf16x8 kf[8];
#pragma unroll
      for (int d0 = 0; d0 < 4; ++d0) { const int cb = colB0 + (d0 * 16 + hi * 8) * 2;
        kf[2 * d0] = *reinterpret_cast<const bf16x8*>(Ks + KSWZ(r32, cb)); kf[2 * d0 + 1] = *reinterpret_cast<const bf16x8*>(Ks + KSWZ(32 + r32, cb));
        if (d0 == 0) SBAR(); }
#define VLD(DST, KS) do { _Pragma("unroll") for (int d0 = 0; d0 < 4; ++d0) { DST[2 * d0] = vtr(vb + v_rd_off(d0, KS, 0)); DST[2 * d0 + 1] = vtr(vb + v_rd_off(d0, KS, 1)); } } while (0)
#define PVM(SRC, PA) do { _Pragma("unroll") for (int d0 = 0; d0 < 4; ++d0) o[d0] = __builtin_amdgcn_mfma_f32_32x32x16_bf16(PA, \
        ((bf16x8){SRC[2 * d0][0], SRC[2 * d0][1], SRC[2 * d0][2], SRC[2 * d0][3], SRC[2 * d0 + 1][0], SRC[2 * d0 + 1][1], SRC[2 * d0 + 1][2], SRC[2 * d0 + 1][3]}), o[d0], 0, 0, 0); } while (0)
      if (j > 0) VLD(va, 0);
      SBAR();
      asm volatile("v_mfma_f32_32x32x16_bf16 %0, %1, %2, %3" : "=&v"(p0) : "v"(kf[0]), "v"(qr[0]), "v"(negm));
      asm volatile("v_mfma_f32_32x32x16_bf16 %0, %1, %2, %3" : "=&v"(p1) : "v"(kf[1]), "v"(qr[0]), "v"(negm));
      SBAR(); ISSUE1(j + 3, j + 2, 0); SBAR();
#pragma unroll
      for (int d0 = 1; d0 < 4; ++d0) {
        p0 = __builtin_amdgcn_mfma_f32_32x32x16_bf16(kf[2 * d0], qr[d0], p0, 0, 0, 0);
        p1 = __builtin_amdgcn_mfma_f32_32x32x16_bf16(kf[2 * d0 + 1], qr[d0], p1, 0, 0, 0);
        SBAR(); ISSUE1(j + 3, j + 2, d0); SBAR(); }
      if (j > 0) {
        VLD(vbq, 1); SBAR();
        PVM(va, pa0); VLD(va, 2); SBAR();
        PVM(vbq, pa1); VLD(vbq, 3); SBAR();
      }
#undef VLD
    }
    if (js == 1) BAR_VL8();
    if (j > 0) { PVM(va, pa2); PVM(vbq, pa3); }
#undef PVM
    float pmaxa = fmaxf(p0[0], p1[0]), pmaxb = fmaxf(p0[1], p1[1]);
#pragma unroll
    for (int r = 2; r < 16; r += 2) { pmaxa = fmaxf(fmaxf(pmaxa, p0[r]), p1[r]); pmaxb = fmaxf(fmaxf(pmaxb, p0[r + 1]), p1[r + 1]); }
    float pmax = fmaxf(pmaxa, pmaxb);
    { auto rr = __builtin_amdgcn_permlane32_swap(__float_as_uint(pmax), __float_as_uint(pmax), false, false);
      pmax = fmaxf(__uint_as_float(rr[0]), __uint_as_float(rr[1])); }
    if (j == 0 || __any(pmax > THRL)) {
      const float dl = (j == 0) ? pmax : fmaxf(pmax, 0.f); m_reg += dl;
#pragma unroll
      for (int r = 0; r < 16; ++r) { p0[r] -= dl; p1[r] -= dl; }
#pragma unroll
      for (int r = 0; r < 16; ++r) negm[r] = -m_reg;
      if (j > 0) { const float al = __builtin_amdgcn_exp2f(-dl); l_reg *= al;
        if (hi == 0) al_l[r32] = al;
        asm volatile("s_waitcnt lgkmcnt(0)" ::: "memory");
#pragma unroll
        for (int d = 0; d < 4; ++d)
#pragma unroll
          for (int r = 0; r < 16; ++r) o[d][r] *= al_l[crow(r, hi)]; }
    }
#pragma unroll
    for (int r = 0; r < 16; ++r) { p0[r] = __builtin_amdgcn_exp2f(p0[r]); p1[r] = __builtin_amdgcn_exp2f(p1[r]); }
    float ps0 = 0.f, ps1 = 0.f, ps2 = 0.f, ps3 = 0.f;
#pragma unroll
    for (int r = 0; r < 16; r += 4) { ps0 += p0[r] + p1[r]; ps1 += p0[r + 1] + p1[r + 1]; ps2 += p0[r + 2] + p1[r + 2]; ps3 += p0[r + 3] + p1[r + 3]; }
    float ps = (ps0 + ps1) + (ps2 + ps3);
    { auto rr = __builtin_amdgcn_permlane32_swap(__float_as_uint(ps), __float_as_uint(ps), false, false);
      ps = __uint_as_float(rr[0]) + __uint_as_float(rr[1]); }
    l_reg += ps;
#define PK4(P, BASE, OUT) do { u32x4 w = {cvtpk(P[BASE + 0], P[BASE + 1]), cvtpk(P[BASE + 2], P[BASE + 3]), cvtpk(P[BASE + 4], P[BASE + 5]), cvtpk(P[BASE + 6], P[BASE + 7])}; OUT = *reinterpret_cast<bf16x8*>(&w); } while (0)
    PK4(p0, 0, pa0); PK4(p0, 8, pa1); PK4(p1, 0, pa2); PK4(p1, 8, pa3);
#undef PK4
    if (js == 0) BAR_VL8();
  }
  pv_all(o, vb0 + ((NT - 1) & 3) * SHM_V, pa0, pa1, pa2, pa3);
  asm volatile("s_waitcnt vmcnt(0) lgkmcnt(0)" ::: "memory");
  if (hi == 0) li_l[r32] = l_reg; asm volatile("s_waitcnt lgkmcnt(0)" ::: "memory");
  float rli[16];
#pragma unroll
  for (int r = 0; r < 16; ++r) rli[r] = __builtin_amdgcn_rcpf(li_l[crow(r, hi)]);
  __syncthreads();
  float* X2 = (float*)lds + qw * (32 * 128);
  if (js == 1) {
#pragma unroll
    for (int r = 0; r < 16; ++r) { const float f = rli[r] * A.lam;
#pragma unroll
      for (int d0 = 0; d0 < 4; ++d0) X2[crow(r, hi) * 128 + d0 * 32 + r32] = o[d0][r] * f; }
  }
  __syncthreads();
  if (js == 0) {
    float gq[4];
#pragma unroll
    for (int d0 = 0; d0 < 4; ++d0) gq[d0] = A.subg[d0 * 32 + r32] * A.oscale;
    bf16_t* Yw = A.YC + (size_t)(qrow0 + qw * QBLK) * LDY + YC_ATT + h * 128 + r32;
#pragma unroll
    for (int r = 0; r < 16; ++r) { float v[4]; float ss = 0.f;
#pragma unroll
      for (int d0 = 0; d0 < 4; ++d0) { v[d0] = o[d0][r] * rli[r] - X2[crow(r, hi) * 128 + d0 * 32 + r32]; ss += v[d0] * v[d0]; }
      ss += __shfl_xor(ss, 1); ss += __shfl_xor(ss, 2); ss += __shfl_xor(ss, 4); ss += __shfl_xor(ss, 8); ss += __shfl_xor(ss, 16);
      const float rn = 1.0f / sqrtf(ss * (1.0f / 128.0f) + 1e-6f);
#pragma unroll
      for (int d0 = 0; d0 < 4; ++d0) { const float y = v[d0] * rn * gq[d0]; Yw[(size_t)crow(r, hi) * LDY + d0 * 32] = (bf16_t)(cvtpk(y, y) & 0xffffu); } }
  }
  asm volatile("s_waitcnt vmcnt(0)" ::: "memory");
  __syncthreads();
#undef TROW
#undef ISSUE
#undef ISSUE1
}
#undef BAR_L
#undef BAR_VL8
#undef KSWZ
#undef SBAR
}
#define GAS __attribute__((address_space(1)))
#define LAS __attribute__((address_space(3)))
typedef unsigned short bf16;
typedef unsigned v4u __attribute__((ext_vector_type(4)));
typedef unsigned v2u __attribute__((ext_vector_type(2)));
typedef float f32x4 __attribute__((ext_vector_type(4)));
typedef short bf16x8 __attribute__((ext_vector_type(8)));
typedef GAS unsigned gu32;
typedef GAS unsigned long long gu64;
#define RLX_AGENT __ATOMIC_RELAXED, __HIP_MEMORY_SCOPE_AGENT
#define LDS_WAIT() asm volatile("s_waitcnt lgkmcnt(0)" ::: "memory")
#define VM_WAIT() asm volatile("s_waitcnt vmcnt(0)" ::: "memory")
__device__ __forceinline__ unsigned long long rt() { return __builtin_amdgcn_s_memrealtime(); }
__device__ __forceinline__ unsigned f2bf(float f) { unsigned u = __builtin_bit_cast(unsigned, f); return (u + 0x7fffu + ((u >> 16) & 1u)) >> 16; }
__device__ __forceinline__ unsigned pk2(float lo, float hi) { return f2bf(lo) | (f2bf(hi) << 16); }
#define XB_TMO      128
#define XB_XCNT(j)  (256  + 64 * (j))
#define XB_XSUB(j)  (1280 + 64 * (j))
#define XB_XGEN(j)  (2304 + 64 * (j))
#define XB_TOP      3328
#define XB_TOPGEN   3392
#define XCD_BAR_WORDS 3456
#define XB_SPIN_CAP (1u << 18)

__device__ __forceinline__ unsigned xb_ld(unsigned* p)              { return __hip_atomic_load(p, __ATOMIC_RELAXED, __HIP_MEMORY_SCOPE_AGENT); }
__device__ __forceinline__ unsigned xb_add(unsigned* p, unsigned v) { return __hip_atomic_fetch_add(p, v, __ATOMIC_RELAXED, __HIP_MEMORY_SCOPE_AGENT); }
__device__ __forceinline__ unsigned xb_xcc_id() { return (unsigned)__builtin_amdgcn_s_getreg((3 << 11) | 20) & 0xFu; }
#define XB_SPIN(cond, bar) do { unsigned _sp = 0; while (cond) { __builtin_amdgcn_s_sleep(1); \
    if ((++_sp & 255u) == 0u) { if (xb_ld(&(bar)[XB_TMO])) break; if (_sp > XB_SPIN_CAP) { atomicAdd(&(bar)[XB_TMO], 1u); break; } } } } while (0)

struct XcdBarrier {
    unsigned* bar; unsigned x;
    volatile LAS unsigned* st;
};

__device__ __forceinline__ XcdBarrier xcd_barrier_post(unsigned* bar, volatile LAS unsigned* st) {
    XcdBarrier b; b.bar = bar; b.x = xb_xcc_id(); b.st = st;
    if (threadIdx.x == 0) (void)xb_add(&bar[XB_XCNT(b.x)], 1u);
    return b;
}
__device__ __forceinline__ void xcd_barrier_complete(unsigned* bar, unsigned x, unsigned& nloc, unsigned& nx) {
    const unsigned G = gridDim.x * gridDim.y * gridDim.z;
    unsigned sum, cnt, mine, sp = 0u;
    for (;;) {
        sum = 0u; cnt = 0u; mine = 0u;
#pragma unroll
        for (unsigned j = 0; j < 16; ++j) { const unsigned c = xb_ld(&bar[XB_XCNT(j)]); sum += c; cnt += (c > 0u) ? 1u : 0u; mine = (j == x) ? c : mine; }
        if (sum == G) break;
        __builtin_amdgcn_s_sleep(1);
        if ((++sp & 255u) == 0u) { if (xb_ld(&bar[XB_TMO])) break; if (sp > XB_SPIN_CAP) { atomicAdd(&bar[XB_TMO], 1u); break; } }
    }
    nloc = mine > 0u ? mine : 1u; nx = cnt > 0u ? cnt : 1u;
}

__device__ __forceinline__ void xcd_barrier(const XcdBarrier& b) {
    asm volatile("s_waitcnt vmcnt(0)" ::: "memory");
    __syncthreads();
    if (threadIdx.x == 0) {
        unsigned* bar = b.bar;
        __builtin_amdgcn_s_waitcnt(0);
        unsigned nloc = b.st[0], nx = b.st[1];
        if (nloc == 0u) { xcd_barrier_complete(bar, b.x, nloc, nx); b.st[0] = nloc; b.st[1] = nx; }
        const unsigned old = xb_add(&bar[XB_XSUB(b.x)], 1u);
        const unsigned gen = old / nloc;
        if (old + 1u == (gen + 1u) * nloc) {
            __builtin_amdgcn_fence(__ATOMIC_RELEASE, "agent");
            asm volatile("s_waitcnt vmcnt(0)" ::: "memory");
            const unsigned og = xb_add(&bar[XB_TOP], 1u);
            const unsigned tg = og / nx;
            if (og + 1u == (tg + 1u) * nx) xb_add(&bar[XB_TOPGEN], 1u);
            else XB_SPIN(xb_ld(&bar[XB_TOPGEN]) == tg, bar);
            __builtin_amdgcn_fence(__ATOMIC_ACQUIRE, "agent");
            xb_add(&bar[XB_XGEN(b.x)], 1u);
            asm volatile("s_waitcnt vmcnt(0)" ::: "memory");
        } else {
            XB_SPIN(xb_ld(&bar[XB_XGEN(b.x)]) == gen, bar);
            __builtin_amdgcn_fence(__ATOMIC_ACQUIRE, "agent");
            asm volatile("s_waitcnt vmcnt(0)" ::: "memory");
        }
    }
    __syncthreads();
}

typedef decltype(__builtin_amdgcn_kernarg_segment_ptr()) kargp_t;
struct Frame {
    LAS unsigned char* lds;
    volatile LAS unsigned* MISC;
    gu32* ctl;
    int tid, lane, wave;
    int vcu, G;
    kargp_t kp;
    float* out;
    unsigned char* ws;
};
#define FIN(i) (((const float* const*)F.kp)[i])
#define WSP(T, off) ((T*)(F.ws + (off)))

__device__ __forceinline__ float wave_sum(float v) {
#pragma unroll
    for (int o = 1; o < 64; o <<= 1) v += __shfl_xor(v, o);
    return v;
}
__device__ __forceinline__ void dsincos(double x, double& s, double& c) {
    const double kd = rint(x * 0.63661977236758134308);
    double r = fma(-kd, 1.57079632679489655800e+00, x); r = fma(-kd, 6.12323399573676603587e-17, r);
    const double r2 = r * r;
    double sp = -1.0 / 1307674368000.0; sp = sp * r2 + 1.0 / 6227020800.0; sp = sp * r2 - 1.0 / 39916800.0; sp = sp * r2 + 1.0 / 362880.0; sp = sp * r2 - 1.0 / 5040.0; sp = sp * r2 + 1.0 / 120.0; sp = sp * r2 - 1.0 / 6.0; sp = sp * r2 * r + r;
    double cp = 1.0 / 20922789888000.0; cp = cp * r2 - 1.0 / 87178291200.0; cp = cp * r2 + 1.0 / 479001600.0; cp = cp * r2 - 1.0 / 3628800.0; cp = cp * r2 + 1.0 / 40320.0; cp = cp * r2 - 1.0 / 720.0; cp = cp * r2 + 1.0 / 24.0; cp = cp * r2 - 0.5; cp = cp * r2 + 1.0;
    const int k = ((int)kd) & 3;
    s = (k == 0) ? sp : (k == 1) ? cp : (k == 2) ? -sp : -cp;
    c = (k == 0) ? cp : (k == 1) ? -sp : (k == 2) ? -cp : sp;
}
__device__ __forceinline__ float silu_f(float a) { return a / (1.0f + __expf(-a)); }

__device__ __forceinline__ void ssm_disc(double dt, float are_f, float aim_f, double& abr, double& abi, double& cfr, double& cfi) {
    const double are = (double)are_f, aim = (double)aim_f, mag = exp(dt * are); double s, c; dsincos(dt * aim, s, c);
    abr = mag * c; abi = mag * s; const double den = are * are + aim * aim, nr = abr - 1.0;
    cfr = (nr * are + abi * aim) / den; cfi = (abi * are - nr * aim) / den;
}
__device__ __forceinline__ void p0_transpose_item(const float* W, int K, int N, bf16* WT, int mode, LAS float* scr, int item, int lane) {
    const int nblk = N / 32, kb = item / nblk, nb = item % nblk, k0 = 64 * kb, n0 = 32 * nb;
#pragma unroll 8
    for (int i = 0; i < 32; ++i) { const int kk = 2 * i + (lane >> 5); scr[kk * 33 + (lane & 31)] = W[(size_t)(k0 + kk) * N + n0 + (lane & 31)]; }
    LDS_WAIT(); asm volatile("" ::: "memory");
    const int c = lane & 7;
#pragma unroll
    for (int j = 0; j < 4; ++j) { const int n = (lane >> 3) + 8 * j; const LAS float* s = scr + (8 * c) * 33 + n;
        v4u o; o.x = pk2(s[0 * 33], s[1 * 33]); o.y = pk2(s[2 * 33], s[3 * 33]); o.z = pk2(s[4 * 33], s[5 * 33]); o.w = pk2(s[6 * 33], s[7 * 33]);
        const int ns = n0 + n; const int drow = (mode == 0) ? ns : ((ns >> 7) * 256 + (mode - 1) * 128 + (ns & 127));
        *(GAS v4u*)(WT + (size_t)drow * K + k0 + 8 * c) = o; }
    LDS_WAIT(); asm volatile("" ::: "memory");
}
constexpr int I_FF1 = (D / 64) * (DFF / 32), I_FF2 = (DFF / 64) * (D / 32), I_IN = (D / 64) * (DIN / 32), I_OUT = (D / 64) * (D / 32), I_GLU = (WSSM / 64) * (WSSM / 32);
constexpr int I_LAYER = 4 * I_FF1 + 2 * I_FF2 + I_IN + I_OUT + I_GLU;
constexpr int SUPER = 64, N_SUPER = 2 * I_LAYER / SUPER;
static_assert((2 * I_LAYER) % SUPER == 0, "super-items");
constexpr int GEMV_COLS = 128, N_GEMV = 2 * (MODW / GEMV_COLS);
__device__ __forceinline__ void p0_convert_item(Frame& F, int it, LAS float* scr) {
    const int l = it / I_LAYER; int r = it % I_LAYER;
    unsigned char* wl = F.ws + WS_W + (size_t)l * W_LAYER;
    if (r < I_FF1) { p0_transpose_item(FIN(6) + (size_t)l * D * DFF, D, DFF, (bf16*)(wl + WL_13A), 1, scr, r, F.lane); return; } r -= I_FF1;
    if (r < I_FF1) { p0_transpose_item(FIN(7) + (size_t)l * D * DFF, D, DFF, (bf16*)(wl + WL_13A), 2, scr, r, F.lane); return; } r -= I_FF1;
    if (r < I_FF2) { p0_transpose_item(FIN(8) + (size_t)l * D * DFF, DFF, D, (bf16*)(wl + WL_2A), 0, scr, r, F.lane); return; } r -= I_FF2;
    if (r < I_FF1) { p0_transpose_item(FIN(9) + (size_t)l * D * DFF, D, DFF, (bf16*)(wl + WL_13B), 1, scr, r, F.lane); return; } r -= I_FF1;
    if (r < I_FF1) { p0_transpose_item(FIN(10) + (size_t)l * D * DFF, D, DFF, (bf16*)(wl + WL_13B), 2, scr, r, F.lane); return; } r -= I_FF1;
    if (r < I_FF2) { p0_transpose_item(FIN(11) + (size_t)l * D * DFF, DFF, D, (bf16*)(wl + WL_2B), 0, scr, r, F.lane); return; } r -= I_FF2;
    if (r < I_IN) { p0_transpose_item(FIN(12) + (size_t)l * D * DIN, D, DIN, (bf16*)(wl + WL_IN), 0, scr, r, F.lane); return; } r -= I_IN;
    if (r < I_OUT) { p0_transpose_item(FIN(13) + (size_t)l * D * D, D, D, (bf16*)(wl + WL_OUT), 0, scr, r, F.lane); return; } r -= I_OUT;
    p0_transpose_item(FIN(28) + (size_t)l * WSSM * WSSM, WSSM, WSSM, (bf16*)(wl + WL_GLU), 0, scr, r, F.lane);
}
__device__ __forceinline__ void p0_gemv_task(Frame& F, int t) {
    const int l = t / (MODW / GEMV_COLS), cb = t % (MODW / GEMV_COLS), col0 = cb * GEMV_COLS;
    const LAS float* sil = (const LAS float*)(F.lds + P0_SIL_OFF);
    LAS float* red = (LAS float*)(F.lds + P0_RED_OFF);
    typedef float f32x2 __attribute__((ext_vector_type(2)));
    const float* wp = FIN(4) + ((size_t)l * D + (size_t)F.wave * 512) * MODW + col0 + 2 * F.lane;
    f32x2 a0 = {0.f, 0.f}, a1 = {0.f, 0.f}, a2 = {0.f, 0.f};
    const int kb = F.wave * 512;
#pragma unroll 8
    for (int k = 0; k < 512; ++k) { const f32x2 w = *(const GAS f32x2*)(wp + (size_t)k * MODW);
        a0 += w * sil[kb + k]; a1 += w * sil[D + kb + k]; a2 += w * sil[2 * D + kb + k]; }
    red[(F.wave * 3 + 0) * GEMV_COLS + 2 * F.lane] = a0.x; red[(F.wave * 3 + 0) * GEMV_COLS + 2 * F.lane + 1] = a0.y;
    red[(F.wave * 3 + 1) * GEMV_COLS + 2 * F.lane] = a1.x; red[(F.wave * 3 + 1) * GEMV_COLS + 2 * F.lane + 1] = a1.y;
    red[(F.wave * 3 + 2) * GEMV_COLS + 2 * F.lane] = a2.x; red[(F.wave * 3 + 2) * GEMV_COLS + 2 * F.lane + 1] = a2.y;
    __syncthreads();
    if (F.tid < 3 * GEMV_COLS) { const int v = F.tid / GEMV_COLS, j = F.tid % GEMV_COLS; float s = 0.f;
#pragma unroll
        for (int w = 0; w < 8; ++w) s += red[(w * 3 + v) * GEMV_COLS + j];
        WSP(float, WS_MOD)[((size_t)l * 3 + v) * MODW + col0 + j] = s + FIN(5)[(size_t)l * MODW + col0 + j]; }
    __syncthreads();
}
__device__ __forceinline__ void p0_prologue(Frame& F, int qword) {
    LAS float* sil = (LAS float*)(F.lds + P0_SIL_OFF);
    for (int i = F.tid; i < 3 * D; i += NWAVES * 64) { const float cv = (i < 2 * D) ? FIN(1)[i] : FIN(3)[i - 2 * D]; sil[i] = silu_f(cv); }
    if (blockIdx.x == 0) {
        for (int i = F.tid; i < 128 * 16; i += NWAVES * 64) { const int pos = i >> 4, k = i & 15;
            const float inv = (float)exp(-(double)k * (9.210340371976184 / 16.0));
            const float ang = (float)pos * inv; double s, c; dsincos((double)ang, s, c);
            WSP(float, WS_ROPE)[pos * 32 + k] = (float)c; WSP(float, WS_ROPE)[pos * 32 + 16 + k] = (float)s; }
    }
    for (int pg = blockIdx.x; pg < 256; pg += F.G) if (F.tid < 64) { const int n = F.tid;
        const double dt = exp((double)FIN(22)[pg]); double abr, abi, cr, ci; ssm_disc(dt, FIN(20)[pg * 64 + n], FIN(21)[pg * 64 + n], abr, abi, cr, ci);
        WSP(float, WS_ABAR)[(pg * 64 + n) * 2] = (float)abr; WSP(float, WS_ABAR)[(pg * 64 + n) * 2 + 1] = (float)abi;
        const float* bre = FIN(23) + ((size_t)pg * 64 + n) * 16; const float* bim = FIN(24) + ((size_t)pg * 64 + n) * 16;
#pragma unroll 4
        for (int p = 0; p < 16; ++p) { WSP(float, WS_BBR)[((size_t)pg * 64 + n) * 16 + p] = (float)(cr * (double)bre[p] - ci * (double)bim[p]);
                                       WSP(float, WS_BBI)[((size_t)pg * 64 + n) * 16 + p] = (float)(cr * (double)bim[p] + ci * (double)bre[p]); } }
    __syncthreads();
    LAS float* scr = (LAS float*)(F.lds + F.wave * 8448);
    LAS unsigned* qslot = (LAS unsigned*)(F.lds + P0_Q_OFF);
    for (;;) {
        if (F.tid == 0) qslot[0] = __hip_atomic_fetch_add(F.ctl + qword, 1u, RLX_AGENT);
        __syncthreads();
        const int t = (int)qslot[0];
        __syncthreads();
        if (t >= N_GEMV + N_SUPER) break;
        if (t < N_GEMV) p0_gemv_task(F, t);
        else { const int base = (t - N_GEMV) * SUPER;
#pragma unroll 1
            for (int i = 0; i < SUPER / NWAVES; ++i) p0_convert_item(F, base + i * NWAVES + F.wave, scr); }
    }
}

__device__ __forceinline__ const float* xrow_ptr(const float* lat, const float* cx, int row) { return row < NLAT ? lat + (size_t)row * D : cx + (size_t)(row - NLAT) * D; }
typedef pg8::f16_t f16_t; typedef pg8::f16x8 f16x8; typedef pg8::f32x8 f32x8;
template <bool X16>
__device__ __forceinline__ void norm_mod_phase(Frame& F, const float* lat, const float* cx, const f16_t* Xs, int nrows, const float* modl, int ish, int isc, bf16* H,
                                               const float* part, const float* pgate, float pscale, const float* pb32, f16_t* Xw) {
    const int gw = F.vcu * NWAVES + F.wave, NGW = F.G * NWAVES; const int c0 = 8 * F.lane;
    LAS float* mlds = (LAS float*)F.lds;
    for (int i = F.tid; i < 3 * 2 * (D / 4); i += NWAVES * 64) { const int set = i / (2 * (D / 4)), r = i % (2 * (D / 4)), which = r / (D / 4), c4 = r % (D / 4);
        ((LAS f32x4*)mlds)[i] = *(const GAS f32x4*)(modl + (size_t)set * MODW + (which ? isc : ish) * D + 4 * c4); }
    __syncthreads();
    for (int row = gw; row < nrows; row += NGW) {
        const int set = row < 8192 ? 0 : (row < NLAT ? 1 : 2);
        const LAS float* sh = mlds + set * (2 * D) + c0; const LAS float* sc = sh + D;
        f32x8 v[8]; float ss = 0.f;
        if (part != nullptr && row >= NLAT) {
            const int rc = row - NLAT;
#pragma unroll
            for (int j = 0; j < 8; ++j) { const int c = c0 + 512 * j; f32x4 s0 = {0.f, 0.f, 0.f, 0.f}, s1 = {0.f, 0.f, 0.f, 0.f};
#pragma unroll
                for (int ks = 0; ks < 8; ++ks) { const float* pp = part + ((size_t)ks * NCTX + rc) * D + c; s0 += *(const GAS f32x4*)pp; s1 += *(const GAS f32x4*)(pp + 4); }
                f32x8 b;
                if (pb32 != nullptr) { const f32x4 b0 = *(const GAS f32x4*)(pb32 + (size_t)rc * D + c), b1 = *(const GAS f32x4*)(pb32 + (size_t)rc * D + c + 4); b = (f32x8){b0[0], b0[1], b0[2], b0[3], b1[0], b1[1], b1[2], b1[3]}; }
                else b = __builtin_convertvector(*(const GAS f16x8*)(Xw + (size_t)row * D + c), f32x8);
                const f32x4 g0 = *(const GAS f32x4*)(pgate + c) * pscale, g1 = *(const GAS f32x4*)(pgate + c + 4) * pscale;
                v[j] = (f32x8){b[0] + g0[0] * s0[0], b[1] + g0[1] * s0[1], b[2] + g0[2] * s0[2], b[3] + g0[3] * s0[3], b[4] + g1[0] * s1[0], b[5] + g1[1] * s1[1], b[6] + g1[2] * s1[2], b[7] + g1[3] * s1[3]};
                *(GAS f16x8*)(Xw + (size_t)row * D + c) = __builtin_convertvector(v[j], f16x8); }
        } else if (X16) {
#pragma unroll
            for (int j = 0; j < 8; ++j) v[j] = __builtin_convertvector(__builtin_nontemporal_load((const GAS f16x8*)(Xs + (size_t)row * D + c0 + 512 * j)), f32x8);
        } else {
            const float* xr = xrow_ptr(lat, cx, row) + c0;
#pragma unroll
            for (int j = 0; j < 8; ++j) { const f32x4 a = *(const GAS f32x4*)(xr + 512 * j), b = *(const GAS f32x4*)(xr + 512 * j + 4); v[j] = (f32x8){a[0], a[1], a[2], a[3], b[0], b[1], b[2], b[3]}; }
        }
#pragma unroll
        for (int j = 0; j < 8; ++j)
#pragma unroll
            for (int x = 0; x < 8; ++x) ss += v[j][x] * v[j][x];
        const float r = 1.0f / sqrtf(wave_sum(ss) * (1.0f / D) + NORM_EPS);
#pragma unroll
        for (int j = 0; j < 8; ++j) { const f32x4 s0 = *(const LAS f32x4*)(sc + 512 * j), s1 = *(const LAS f32x4*)(sc + 512 * j + 4), h0 = *(const LAS f32x4*)(sh + 512 * j), h1 = *(const LAS f32x4*)(sh + 512 * j + 4);
            v4u o; o.x = pk2(v[j][0] * r * (s0[0] + 1.0f) + h0[0], v[j][1] * r * (s0[1] + 1.0f) + h0[1]); o.y = pk2(v[j][2] * r * (s0[2] + 1.0f) + h0[2], v[j][3] * r * (s0[3] + 1.0f) + h0[3]);
            o.z = pk2(v[j][4] * r * (s1[0] + 1.0f) + h1[0], v[j][5] * r * (s1[1] + 1.0f) + h1[1]); o.w = pk2(v[j][6] * r * (s1[2] + 1.0f) + h1[2], v[j][7] * r * (s1[3] + 1.0f) + h1[3]);
            *(GAS v4u*)(H + (size_t)row * D + c0 + 512 * j) = o; }
    }
}
__device__ __forceinline__ void final_norm_phase(Frame& F) {
    const int gw = F.vcu * NWAVES + F.wave, NGW = F.G * NWAVES; const int c0 = 8 * F.lane;
    LAS float* gl = (LAS float*)F.lds;
    for (int i = F.tid; i < D / 4; i += NWAVES * 64) ((LAS f32x4*)gl)[i] = ((const GAS f32x4*)FIN(29))[i];
    __syncthreads();
    const LAS float* gp = gl + c0; const f16_t* Xs = WSP(f16_t, WS_X);
    for (int row = gw; row < NLAT; row += NGW) {
        f32x8 v[8]; float ss = 0.f;
#pragma unroll
        for (int j = 0; j < 8; ++j) v[j] = __builtin_convertvector(__builtin_nontemporal_load((const GAS f16x8*)(Xs + (size_t)row * D + c0 + 512 * j)), f32x8);
#pragma unroll
        for (int j = 0; j < 8; ++j)
#pragma unroll
            for (int x = 0; x < 8; ++x) ss += v[j][x] * v[j][x];
        const float r = 1.0f / sqrtf(wave_sum(ss) * (1.0f / D) + NORM_EPS);
        float* o = F.out + (size_t)row * D + c0;
#pragma unroll
        for (int j = 0; j < 8; ++j) { const f32x4 g0 = *(const LAS f32x4*)(gp + 512 * j), g1 = *(const LAS f32x4*)(gp + 512 * j + 4);
            *(GAS f32x4*)(o + 512 * j) = (f32x4){v[j][0] * r * g0[0], v[j][1] * r * g0[1], v[j][2] * r * g0[2], v[j][3] * r * g0[3]};
            *(GAS f32x4*)(o + 512 * j + 4) = (f32x4){v[j][4] * r * g1[0], v[j][5] * r * g1[1], v[j][6] * r * g1[2], v[j][7] * r * g1[3]}; }
    }
}
__device__ __forceinline__ void unpack8(const v4u w, float (&f)[8]) {
    f[0] = pg8::bf_lo(w.x); f[1] = pg8::bf_hi(w.x); f[2] = pg8::bf_lo(w.y); f[3] = pg8::bf_hi(w.y); f[4] = pg8::bf_lo(w.z); f[5] = pg8::bf_hi(w.z); f[6] = pg8::bf_lo(w.w); f[7] = pg8::bf_hi(w.w);
}
__device__ __forceinline__ void conv_phase(Frame& F, int l, int nrows) {
    const int gw = F.vcu * NWAVES + F.wave, NGW = F.G * NWAVES;
    const bf16* P = WSP(bf16, WS_P); bf16* YC = WSP(bf16, WS_YCAT);
    LAS float* cw = (LAS float*)F.lds;
    for (int i = F.tid; i < 3 * WCONV / 4; i += NWAVES * 64) ((LAS f32x4*)cw)[i] = ((const GAS f32x4*)(FIN(14) + (size_t)l * 3 * WCONV))[i];
    __syncthreads();
    for (int row = gw; row < nrows; row += NGW) {
        int t, len; if (row < NLAT) { t = row & 8191; len = 8192; } else { t = (row - NLAT) & 255; len = 256; }
        const bool hp = t > 0, hn = t + 1 < len;
#pragma unroll
        for (int hv = 0; hv < 2; ++hv) { const int c0 = F.lane * 16 + hv * 8;
            const bf16* p0 = P + (size_t)row * LDP + c0;
            float h0[8], b0[8], g0[8], hm[8], gm[8], hq[8], gq[8];
            unpack8(*(const GAS v4u*)(p0), h0); unpack8(*(const GAS v4u*)(p0 + WCONV), b0); unpack8(*(const GAS v4u*)(p0 + 2 * WCONV), g0);
            if (hp) { unpack8(*(const GAS v4u*)(p0 - LDP), hm); unpack8(*(const GAS v4u*)(p0 - LDP + 2 * WCONV), gm); }
            if (hn) { unpack8(*(const GAS v4u*)(p0 + LDP), hq); unpack8(*(const GAS v4u*)(p0 + LDP + 2 * WCONV), gq); }
            float o[8];
#pragma unroll
            for (int x = 0; x < 8; ++x) { const float zm = hp ? gm[x] * hm[x] : 0.f, z0 = g0[x] * h0[x], zq = hn ? gq[x] * hq[x] : 0.f;
                o[x] = b0[x] * (zm * cw[c0 + x] + z0 * cw[WCONV + c0 + x] + zq * cw[2 * WCONV + c0 + x]); }
            v4u w; w.x = pk2(o[0], o[1]); w.y = pk2(o[2], o[3]); w.z = pk2(o[4], o[5]); w.w = pk2(o[6], o[7]);
            *(GAS v4u*)(YC + (size_t)row * D + c0) = w; }
    }
}
__device__ __forceinline__ float gelu_tanh(float y) { const float u = 1.5957691216057308f * (y + 0.044715f * y * y * y); return y / (1.0f + __expf(-u)); }
__device__ __forceinline__ void ssm_combine_phase(Frame& F, int l, int nrows) {
    const bf16* P = WSP(bf16, WS_P); const bf16* YF = WSP(bf16, WS_YF); const bf16* YR = WSP(bf16, WS_YR); bf16* YP = WSP(bf16, WS_YPRE);
    const float* dsk = FIN(27) + (size_t)l * WSSM;
    const size_t total = (size_t)nrows * (WSSM / 8), stride = (size_t)F.G * NWAVES * 64;
    for (size_t i = (size_t)F.vcu * NWAVES * 64 + F.tid; i < total; i += stride) { const size_t row = i >> 7; const int c = (int)(i & 127) * 8;
        float u[8]; unpack8(*(const GAS v4u*)(P + row * LDP + OFF_U + c), u);
        float ff[8], rr[8]; unpack8(*(const GAS v4u*)(YF + row * WSSM + c), ff); unpack8(*(const GAS v4u*)(YR + row * WSSM + c), rr);
        const f32x4 f0 = {ff[0], ff[1], ff[2], ff[3]}, f1 = {ff[4], ff[5], ff[6], ff[7]}, r0 = {rr[0], rr[1], rr[2], rr[3]}, r1 = {rr[4], rr[5], rr[6], rr[7]};
        const f32x4 d0 = *(const GAS f32x4*)(dsk + c), d1 = *(const GAS f32x4*)(dsk + c + 4);
        float y[8];
        y[0] = d0.x * u[0] + f0.x + r0.x; y[1] = d0.y * u[1] + f0.y + r0.y; y[2] = d0.z * u[2] + f0.z + r0.z; y[3] = d0.w * u[3] + f0.w + r0.w;
        y[4] = d1.x * u[4] + f1.x + r1.x; y[5] = d1.y * u[5] + f1.y + r1.y; y[6] = d1.z * u[6] + f1.z + r1.z; y[7] = d1.w * u[7] + f1.w + r1.w;
#pragma unroll
        for (int x = 0; x < 8; ++x) y[x] = gelu_tanh(y[x]);
        v4u w; w.x = pk2(y[0], y[1]); w.y = pk2(y[2], y[3]); w.z = pk2(y[4], y[5]); w.w = pk2(y[6], y[7]);
        *(GAS v4u*)(YP + row * WSSM + c) = w; }
}

__device__ __forceinline__ int ssm_row(int si, int dir, int b) {
    if (si < CTXL) return NLAT + b * CTXL + (dir ? CTXL - 1 - si : si);
    const int li = si - CTXL; return b * SEQ + (dir ? SEQ - 1 - li : li);
}
__device__ __forceinline__ void split8(const float (&v)[8], bf16x8& hi8, bf16x8& lo8) {
    v4u h, lo; float rs[8];
    h.x = pg8::cvt_pk_bf16(v[0], v[1]); h.y = pg8::cvt_pk_bf16(v[2], v[3]); h.z = pg8::cvt_pk_bf16(v[4], v[5]); h.w = pg8::cvt_pk_bf16(v[6], v[7]);
    rs[0] = v[0] - pg8::bf_lo(h.x); rs[1] = v[1] - pg8::bf_hi(h.x); rs[2] = v[2] - pg8::bf_lo(h.y); rs[3] = v[3] - pg8::bf_hi(h.y);
    rs[4] = v[4] - pg8::bf_lo(h.z); rs[5] = v[5] - pg8::bf_hi(h.z); rs[6] = v[6] - pg8::bf_lo(h.w); rs[7] = v[7] - pg8::bf_hi(h.w);
    lo.x = pg8::cvt_pk_bf16(rs[0], rs[1]); lo.y = pg8::cvt_pk_bf16(rs[2], rs[3]); lo.z = pg8::cvt_pk_bf16(rs[4], rs[5]); lo.w = pg8::cvt_pk_bf16(rs[6], rs[7]);
    hi8 = __builtin_bit_cast(bf16x8, h); lo8 = __builtin_bit_cast(bf16x8, lo);
}
__device__ __forceinline__ int crow16(int r, int hi) { return (r & 3) + 8 * (r >> 2) + 4 * hi; }
template <int ABL = 0> __device__ __forceinline__ void ssm_task(Frame& F, int l, int task) {
    typedef float f32x16 __attribute__((ext_vector_type(16)));
    typedef float f32x2 __attribute__((ext_vector_type(2)));
    constexpr int NCH = (CTXL + SEQ) / 64, HS = 132;
    const int b = task >> 7, dir = (task >> 6) & 1, g = task & 63, pg = (l * 2 + dir) * 64 + g;
    const int wv = F.wave, lane = F.lane, r32 = lane & 31, hi = lane >> 5, fr = lane & 15, fq = lane >> 4;
    const int w = (wv == 0) ? 0 : (wv <= 3) ? wv : (wv == 5) ? 4 : (wv == 4) ? 9 : (wv == 6) ? 5 : 6;
    LAS float* BU = (LAS float*)(F.lds);
    LAS float* HB = (LAS float*)(F.lds + 65536);
    const bf16* P = WSP(bf16, WS_P); bf16* Yout = ABL ? WSP(bf16, WS_HID) : (dir ? WSP(bf16, WS_YR) : WSP(bf16, WS_YF));
    f32x2 aa = {0.f, 0.f}, na = {0.f, 0.f}, h = {0.f, 0.f};
    bf16x8 Rh[4], Rl[4];
#pragma unroll
    for (int q = 0; q < 4; ++q) { Rh[q] = bf16x8{}; Rl[q] = bf16x8{}; }
    if (w == 0) { const float ar = WSP(float, WS_ABAR)[(pg * 64 + lane) * 2], ai = WSP(float, WS_ABAR)[(pg * 64 + lane) * 2 + 1]; aa = (f32x2){ar, ar}; na = (f32x2){-ai, ai}; }
    else if (w <= 4) {
        const float* cre = FIN(25) + ((size_t)pg * 16 + fr) * 64; const float* cim = FIN(26) + ((size_t)pg * 16 + fr) * 64;
#pragma unroll
        for (int ks = 0; ks < 4; ++ks) { float v[8];
#pragma unroll
            for (int x = 0; x < 8; ++x) { const int n = 16 * ks + 4 * fq + (x >> 1); v[x] = (x & 1) ? -cim[n] : cre[n]; }
            split8(v, Rh[ks], Rl[ks]); }
    } else if (w <= 6) {
#pragma unroll
        for (int nb = 0; nb < 4; ++nb) { const int n = 32 * (nb & 1) + r32;
            const float* bb = ((nb < 2) ? WSP(float, WS_BBR) : WSP(float, WS_BBI)) + ((size_t)pg * 64 + n) * 16 + 8 * hi; float v[8];
#pragma unroll
            for (int x = 0; x < 8; ++x) v[x] = bb[x];
            split8(v, Rh[nb], Rl[nb]); }
    }
#define SSM_UDMA(CH) do { const int ch_ = (CH) < NCH ? (CH) : NCH - 1; _Pragma("unroll") for (int i_ = 0; i_ < 2; ++i_) { \
        const bf16* src_ = P + (size_t)ssm_row(64 * ch_ + 32 * i_ + (lane >> 1), dir, b) * LDP + OFF_U + 16 * g + 8 * (lane & 1); \
        att::glds16(src_, (unsigned)__builtin_amdgcn_readfirstlane(uring0 + ((CH) & 3) * 2048 + i_ * 1024)); } } while (0)
    const unsigned uring0 = (unsigned)(uintptr_t)(F.lds + SSM_URING_OFF);
    if (w == 6) { SSM_UDMA(0); SSM_UDMA(1); SSM_UDMA(2); asm volatile("s_waitcnt vmcnt(4)" ::: "memory"); }
    __syncthreads();
    for (int c = -1; c <= NCH; ++c) {
        if (w == 0) {
            if (ABL != 1 && ABL != 4 && c >= 0 && c < NCH) { const LAS f32x2* bu = (const LAS f32x2*)(BU + (c & 1) * (64 * 128)) + lane; LAS f32x2* hb = (LAS f32x2*)(HB + (c & 1) * (64 * HS)) + lane;
                f32x2 cur[16], nxt[16];
#pragma unroll
                for (int q = 0; q < 16; ++q) cur[q] = bu[q * 64];
#pragma unroll
                for (int blk = 0; blk < 4; ++blk) {
                    if (blk < 3) {
#pragma unroll
                        for (int q = 0; q < 16; ++q) nxt[q] = bu[(16 * (blk + 1) + q) * 64]; }
#pragma unroll
                    for (int q = 0; q < 16; ++q) { const f32x2 hs = {h.y, h.x}; const f32x2 t = na * hs + cur[q]; h = aa * h + t; hb[(16 * blk + q) * (HS / 2)] = h; }
#pragma unroll
                    for (int q = 0; q < 16; ++q) cur[q] = nxt[q];
                } }
        } else if (w <= 4) {
            if (ABL != 2 && ABL != 4 && c >= 1) { const int ch = c - 1, rb = w - 1; const LAS float* hrow = HB + (ch & 1) * (64 * HS) + (16 * rb + fr) * HS + 8 * fq;
                f32x4 acc = {0.f, 0.f, 0.f, 0.f};
#pragma unroll
                for (int ks = 0; ks < 4; ++ks) { const f32x4 x0 = *(const LAS f32x4*)(hrow + 32 * ks), x1 = *(const LAS f32x4*)(hrow + 32 * ks + 4);
                    const float v[8] = {x0.x, x0.y, x0.z, x0.w, x1.x, x1.y, x1.z, x1.w}; bf16x8 Hh, Hl; split8(v, Hh, Hl);
                    acc = __builtin_amdgcn_mfma_f32_16x16x32_bf16(Rh[ks], Hh, acc, 0, 0, 0);
                    acc = __builtin_amdgcn_mfma_f32_16x16x32_bf16(Rl[ks], Hh, acc, 0, 0, 0);
                    acc = __builtin_amdgcn_mfma_f32_16x16x32_bf16(Rh[ks], Hl, acc, 0, 0, 0); }
                const int row = ssm_row(64 * ch + 16 * rb + fr, dir, b);
                v2u yo; yo.x = pg8::cvt_pk_bf16(acc.x, acc.y); yo.y = pg8::cvt_pk_bf16(acc.z, acc.w);
                *(GAS v2u*)(Yout + (size_t)row * WSSM + 16 * g + 4 * fq) = yo; }
        } else if (w <= 6) {
            if (w == 6) SSM_UDMA(c + 4);
            if (ABL != 3 && ABL != 4 && c + 1 < NCH) { const int ch = c + 1; const LAS unsigned char* us = F.lds + SSM_URING_OFF + (ch & 3) * 2048 + r32 * 32 + hi * 16;
                const bf16x8 a0 = *(const LAS bf16x8*)us, a1 = *(const LAS bf16x8*)(us + 1024);
                LAS float* buw = BU + (ch & 1) * (64 * 128);
#pragma unroll
                for (int ti = 0; ti < 8; ++ti) if (ti / 4 == w - 5) { const int sb = ti >> 2, nb = ti & 3;
                    f32x16 d = {}; d = __builtin_amdgcn_mfma_f32_32x32x16_bf16(sb ? a1 : a0, Rh[nb], d, 0, 0, 0); d = __builtin_amdgcn_mfma_f32_32x32x16_bf16(sb ? a1 : a0, Rl[nb], d, 0, 0, 0);
                    LAS float* dst = buw + (32 * sb) * 128 + 2 * (32 * (nb & 1) + r32) + (nb >> 1);
#pragma unroll
                    for (int r = 0; r < 16; ++r) dst[crow16(r, hi) * 128] = d[r]; } }
            if (w == 6) asm volatile("s_waitcnt vmcnt(4)" ::: "memory");
        }
        __syncthreads();
    }
    if (w == 6) asm volatile("s_waitcnt vmcnt(0)" ::: "memory");
    __syncthreads();
#undef SSM_UDMA
}

__device__ __forceinline__ void phase_stagger(int c, unsigned ticks_per_group) {
    const unsigned long long t0 = __builtin_amdgcn_s_memrealtime(); const unsigned long long want = (unsigned long long)((unsigned)(c & 3) * ticks_per_group);
    while (__builtin_amdgcn_s_memrealtime() - t0 < want) __builtin_amdgcn_s_sleep(16);
}
#ifndef PROBE_REP_NORM
#define PROBE_REP_NORM 1
#endif
#ifndef PROBE_REP_G1
#define PROBE_REP_G1 1
#endif
#ifndef STAGGER_TICKS
#define STAGGER_TICKS 650u
#endif
#ifndef PROBE_REP_P0
#define PROBE_REP_P0 1
#endif
#ifndef PROBE_REP_G2
#define PROBE_REP_G2 1
#endif
#ifndef PROBE_REP_G4
#define PROBE_REP_G4 1
#endif
#ifndef PROBE_REP_G3
#define PROBE_REP_G3 1
#endif
#ifndef PROBE_REP_SSM
#define PROBE_REP_SSM 1
#endif
#ifndef PROBE_REP_ATT
#define PROBE_REP_ATT 1
#endif
#ifndef PROBE_REP_GLU
#define PROBE_REP_GLU 1
#endif
struct Args { const float* in[NIN]; float* out; unsigned char* ws; int ph_lo, ph_hi; };
constexpr int N_PHASES = 26;
__global__ void __launch_bounds__(NWAVES * 64, 2) fwd_kernel(Args args) {
    extern __shared__ __attribute__((aligned(16))) unsigned char lds[];
    Frame F;
    F.lds = (LAS unsigned char*)lds;
    F.MISC = (volatile LAS unsigned*)(F.lds + MISC_OFF);
    F.tid = threadIdx.x; F.lane = F.tid & 63; F.wave = __builtin_amdgcn_readfirstlane(F.tid >> 6);
    F.G = gridDim.x; { const int bx = blockIdx.x; F.vcu = (F.G % 8 == 0) ? (bx % 8) * (F.G / 8) + bx / 8 : bx; }
    F.ws = args.ws; F.out = args.out; F.ctl = (gu32*)(args.ws + WS_CTL); F.kp = __builtin_amdgcn_kernarg_segment_ptr();
#define PHASE_ENTER() do { int t_ = threadIdx.x; asm volatile("" : "+v"(t_)); F.tid = t_; F.lane = t_ & 63; F.wave = __builtin_amdgcn_readfirstlane(t_ >> 6); \
        kargp_t k_ = __builtin_amdgcn_kernarg_segment_ptr(); asm volatile("" : "+s"(k_)); F.kp = k_; } while (0)
    for (int u = F.tid; u < (LDS_BYTES - LDSCTL_OFF) / 4; u += NWAVES * 64) ((LAS unsigned*)(F.lds + LDSCTL_OFF))[u] = 0u;
    __syncthreads();
    const int lo = args.ph_lo, hi = args.ph_hi;
    XcdBarrier bar; bar.bar = (unsigned*)(F.ctl + CW_BAR); bar.x = 0; bar.st = nullptr;
    if (hi - lo > 1) bar = xcd_barrier_post((unsigned*)(F.ctl + CW_BAR), F.MISC + 8);
#define IN(k) (lo <= (k) && (k) < hi)
#define INP(k) (IN(k) && ({ PHASE_ENTER(); true; }))
#ifndef PROBE_REP_BAR
#define PROBE_REP_BAR 1
#endif
#define SEAM(k) do { if (IN(k) && IN((k) + 1)) for (int rb_ = 0; rb_ < PROBE_REP_BAR; ++rb_) xcd_barrier(bar); } while (0)


#ifndef PROBE_CLOCK_GBLK
#define PROBE_CLOCK_GBLK 0
#endif
#ifdef PROBE_CLOCK
#define CLK_A(slot) do { if (blockIdx.x == 0 && threadIdx.x == 0) { const unsigned long long t_ = __builtin_amdgcn_s_memtime(), r_ = __builtin_amdgcn_s_memrealtime(); \
        F.MISC[32 + 4 * (slot)] = (unsigned)t_; F.MISC[33 + 4 * (slot)] = (unsigned)(t_ >> 32); F.MISC[34 + 4 * (slot)] = (unsigned)r_; F.MISC[35 + 4 * (slot)] = (unsigned)(r_ >> 32); } } while (0)
#define CLK_B(slot) do { if (blockIdx.x == 0 && threadIdx.x == 0) { const unsigned long long t_ = __builtin_amdgcn_s_memtime(), r_ = __builtin_amdgcn_s_memrealtime(); \
        const unsigned long long t0_ = (unsigned long long)F.MISC[32 + 4 * (slot)] | ((unsigned long long)F.MISC[33 + 4 * (slot)] << 32), r0_ = (unsigned long long)F.MISC[34 + 4 * (slot)] | ((unsigned long long)F.MISC[35 + 4 * (slot)] << 32); \
        F.MISC[48 + (slot)] = (unsigned)((float)(t_ - t0_) * 100.0f / (float)(r_ - r0_)); } } while (0)
#else
#define CLK_A(slot) do {} while (0)
#define CLK_B(slot) do {} while (0)
#endif
    #ifndef SKIP_P0
    if (INP(0)) { p0_prologue(F, CW_QUEUE); for (int rep_ = 1; rep_ < PROBE_REP_P0; ++rep_) p0_prologue(F, CW_QUEUE + 64 * rep_); }
#endif
    SEAM(0);

    f16_t* X = WSP(f16_t, WS_X); bf16* H = WSP(bf16, WS_H); bf16* HID = WSP(bf16, WS_HID); bf16* P = WSP(bf16, WS_P); bf16* YC = WSP(bf16, WS_YCAT); bf16* YP = WSP(bf16, WS_YPRE);
    for (int blk = 0; blk < 6; ++blk) {
        const int l = blk / 3, kind = blk % 3;
        const float* modl = WSP(float, WS_MOD) + (size_t)l * 3 * MODW;
        unsigned char* wl = F.ws + WS_W + (size_t)l * W_LAYER;
        const bool pend = (blk >= 1 && blk <= 4);
        const int pk = (blk + 2) % 3, plr = (blk >= 1) ? (blk - 1) / 3 : 0;
        const float* pgate = WSP(float, WS_MOD) + (size_t)plr * 3 * MODW + 2 * MODW + (pk == 0 ? 2 : (pk == 1 ? 5 : 8)) * D;
        const float pscale = (pk == 1) ? 1.0f : 0.5f;
        const float* part = pend ? WSP(float, WS_PART) : nullptr;
        if (kind != 1) {
            const int pb = 1 + 12 * l + (kind == 2 ? 9 : 0);
            const int Mx = (blk == 5) ? NLAT : MROWS;
            const bool first = (blk == 0);
            const float* xl = first ? FIN(0) : nullptr; const float* xc = first ? FIN(2) : nullptr;
            const int im = (kind == 0) ? 0 : 6;
#ifndef SKIP_NORM
            if (INP(pb)) { if (first) norm_mod_phase<false>(F, xl, xc, X, Mx, modl, im, im + 1, H, nullptr, pgate, pscale, nullptr, X);
                           else for (int rep_ = 0; rep_ < PROBE_REP_NORM; ++rep_) norm_mod_phase<true>(F, nullptr, nullptr, X, Mx, modl, im, im + 1, H, part, pgate, pscale, nullptr, X); }
#endif
            SEAM(pb);
#ifndef SKIP_G1
            if (INP(pb + 1)) { if (blk == PROBE_CLOCK_GBLK) CLK_A(0); pg8::Gemm g{H, (const bf16*)(wl + (kind == 0 ? WL_13A : WL_13B)), Mx, 2 * DFF, D}; pg8::HandoffOrder<2, 30> S; S.init(NLAT, Mx - NLAT, 2 * DFF, D, F.G, (int)blockIdx.x, WSP(float, WS_PART), CW_FLAG + blk * 256);
                pg8::EpiSwiGLU E{HID, DFF};
                for (int rep_ = 0; rep_ < PROBE_REP_G1; ++rep_) pg8::gemm_phase<pg8::EpiSwiGLU, pg8::HandoffOrder<2, 30>, true, true>(F.lds, g, S, E); if (blk == PROBE_CLOCK_GBLK) CLK_B(0); }
#endif
            SEAM(pb + 1);
#ifndef SKIP_G2
            if (INP(pb + 2)) { pg8::Gemm g{HID, (const bf16*)(wl + (kind == 0 ? WL_2A : WL_2B)), Mx, D, DFF}; pg8::SplitOrder S; S.init(NLAT, Mx - NLAT, D, DFF, 8, F.G, (int)blockIdx.x);
                pg8::EpiResid E{xl, xc, X, modl + (im + 2) * D, 0.5f, WSP(float, WS_PART)};
#if defined(PROBE_G2_NULLEPI)
                for (int rep_ = 1; rep_ < PROBE_REP_G2; ++rep_) { pg8::EpiNull E2{WSP(float, WS_P)}; pg8::gemm_phase<pg8::EpiNull, pg8::SplitOrder, true, true>(F.lds, g, S, E2); }
#else
                for (int rep_ = 1; rep_ < PROBE_REP_G2; ++rep_) { pg8::EpiResid E2{xl, xc, WSP(f16_t, WS_P), modl + (im + 2) * D, 0.5f, WSP(float, WS_PART)}; pg8::gemm_phase<pg8::EpiResid, pg8::SplitOrder, true, true>(F.lds, g, S, E2); }
#endif
                pg8::gemm_phase<pg8::EpiResid, pg8::SplitOrder, true, true>(F.lds, g, S, E); }
#endif
            SEAM(pb + 2);
        } else {
            const int pb = 1 + 12 * l + 3;
            const int Mo = (l == 1) ? NLAT : MROWS;
#ifndef SKIP_NORM
            if (INP(pb)) for (int rep_ = 0; rep_ < PROBE_REP_NORM; ++rep_) norm_mod_phase<true>(F, nullptr, nullptr, X, MROWS, modl, 3, 4, H, part, pgate, pscale, (blk == 1) ? FIN(2) : nullptr, X);
#endif
            SEAM(pb);
#ifndef SKIP_G3
            if (INP(pb + 1)) { pg8::Gemm g{H, (const bf16*)(wl + WL_IN), MROWS, DIN, D}; pg8::HandoffOrder<3, 20> S; S.init(NLAT, NCTX, DIN, D, F.G, (int)blockIdx.x, WSP(float, WS_PART), CW_FLAG + blk * 256);
                pg8::EpiRope E{P, DIN, WSP(float, WS_ROPE)};
                for (int rep_ = 0; rep_ < PROBE_REP_G3; ++rep_) pg8::gemm_phase<pg8::EpiRope, pg8::HandoffOrder<3, 20>, true, true>(F.lds, g, S, E); }
#endif
            SEAM(pb + 1);
            if (INP(pb + 2)) {
#ifndef SKIP_SSM
#ifdef PROBE_SSM_ABL
                for (int t = blockIdx.x; t < 256; t += F.G) ssm_task<PROBE_SSM_ABL>(F, l, t);
#endif
                for (int rep_ = 0; rep_ < PROBE_REP_SSM; ++rep_) for (int t = blockIdx.x; t < 256; t += F.G) ssm_task<0>(F, l, t);
#endif
#ifndef SKIP_CONV
                for (int rep_ = 0; rep_ < PROBE_REP_NORM; ++rep_) conv_phase(F, l, Mo);
#endif
            }
            SEAM(pb + 2);
#ifndef SKIP_COMB
            if (INP(pb + 3)) for (int rep_ = 0; rep_ < PROBE_REP_NORM; ++rep_) ssm_combine_phase(F, l, Mo);
#endif
            SEAM(pb + 3);
            if (INP(pb + 4)) {
#ifndef SKIP_ATT
                const float d1 = wave_sum(FIN(15)[l * 64 + F.lane] * FIN(16)[l * 64 + F.lane]), d2 = wave_sum(FIN(17)[l * 64 + F.lane] * FIN(18)[l * 64 + F.lane]);
                const float lam_init = (l == 0) ? 0.2f : 0.355509067590969f;
                att::AttnArgs A{P, YC, FIN(19) + l * 128, __expf(d1) - __expf(d2) + lam_init, 1.0f - lam_init};
                const int nunits = (l == 0) ? 2048 + 64 : 2048;
                if (l == 0) CLK_A(1);
                for (int rep_ = 0; rep_ < PROBE_REP_ATT; ++rep_) for (int e = F.vcu; e < nunits; e += F.G) {
                    if (e < 2048) { const int bh = e >> 6, qb = e & 63, b = bh >> 4, h = bh & 15;
                        att::attn_unit(A, b * SEQ + qb * 128, h, b * SEQ, SEQ / 64, NLAT + b * CTXL, (SEQ + CTXL) / 64, (char*)lds); }
                    else { const int e2 = e - 2048, bh = e2 >> 1, qb = e2 & 1, b = bh >> 4, h = bh & 15;
                        att::attn_unit(A, NLAT + b * CTXL + qb * 128, h, 0, 0, NLAT + b * CTXL, CTXL / 64, (char*)lds); }
                }
                if (l == 0) CLK_B(1);
#endif
#ifndef SKIP_GLU
                pg8::Gemm g{YP, (const bf16*)(wl + WL_GLU), Mo, WSSM, WSSM}; pg8::StaticOrder S; S.init(Mo, WSSM, F.G, (int)blockIdx.x);
                pg8::EpiGlu E{YP, WSSM, YC, D, WCONV + WATT};
                for (int rep_ = 0; rep_ < PROBE_REP_GLU; ++rep_) pg8::gemm_phase<pg8::EpiGlu, pg8::StaticOrder, true, true>(F.lds, g, S, E);
#endif
            }
            SEAM(pb + 4);
#ifndef SKIP_G4
            if (INP(pb + 5)) { pg8::Gemm g{YC, (const bf16*)(wl + WL_OUT), Mo, D, D}; pg8::SplitOrder S; S.init(NLAT, Mo - NLAT, D, D, 8, F.G, (int)blockIdx.x);
                pg8::EpiResid E{nullptr, nullptr, X, modl + 5 * D, 1.0f, WSP(float, WS_PART)};
                for (int rep_ = 1; rep_ < PROBE_REP_G4; ++rep_) { pg8::EpiResid E2{nullptr, nullptr, WSP(f16_t, WS_P), modl + 5 * D, 1.0f, WSP(float, WS_PART)}; pg8::gemm_phase<pg8::EpiResid, pg8::SplitOrder, true, true>(F.lds, g, S, E2); }
                pg8::gemm_phase<pg8::EpiResid, pg8::SplitOrder, true, true>(F.lds, g, S, E); }
#endif
            SEAM(pb + 5);
        }
    }
#ifndef SKIP_FIN
    if (INP(25)) final_norm_phase(F);
#endif
#ifdef PROBE_CLOCK
    if (blockIdx.x == 0 && threadIdx.x == 0) { const unsigned g_ = F.MISC[48], a_ = F.MISC[49];
        const unsigned long long ticks = (unsigned long long)(((g_ + 25u) / 50u) * 3000u + a_) * 100ull, s_ = __builtin_amdgcn_s_memrealtime();
        while (__builtin_amdgcn_s_memrealtime() - s_ < ticks) __builtin_amdgcn_s_sleep(32); }
#endif
#undef IN
#undef SEAM
}

#ifndef MK_ONE_LAUNCH
#define MK_ONE_LAUNCH 1
#endif
extern "C" void kernel_launch(void* const* d_in, const int* in_sizes, int n_in, void* d_out, int out_size, void* d_ws, size_t ws_size, hipStream_t stream) {
    static int grid = 0;
    if (grid == 0) {
        if (n_in != NIN || in_sizes[0] != NLAT * D || out_size != NLAT * D || ws_size < WS_END) {
            fprintf(stderr, "kernel_launch: shape mismatch: n_in %d in0 %d out %d ws %zu (need %zu)\n", n_in, n_in > 0 ? in_sizes[0] : -1, out_size, ws_size, (size_t)WS_END); grid = -1; return; }
        int dev = 0, cus = 0, per_cu = 0;
        if (hipGetDevice(&dev) != hipSuccess || hipDeviceGetAttribute(&cus, hipDeviceAttributeMultiprocessorCount, dev) != hipSuccess) { fprintf(stderr, "kernel_launch: device query failed\n"); grid = -1; return; }
        if (hipFuncSetAttribute((const void*)fwd_kernel, hipFuncAttributeMaxDynamicSharedMemorySize, LDS_BYTES) != hipSuccess) { fprintf(stderr, "kernel_launch: hipFuncSetAttribute failed\n"); grid = -1; return; }
        if (hipOccupancyMaxActiveBlocksPerMultiprocessor(&per_cu, (const void*)fwd_kernel, NWAVES * 64, LDS_BYTES) != hipSuccess || per_cu < 1)
            fprintf(stderr, "kernel_launch: note: occupancy query reports %d workgroups per CU\n", per_cu);
        (void)hipGetLastError();
        grid = cus;
    }
    if (grid < 0) return;
    if (hipMemsetAsync((char*)d_ws + WS_CTL, 0, CTL_ZERO_BYTES, stream) != hipSuccess) { fprintf(stderr, "kernel_launch: memset failed\n"); return; }
    Args a{};
    for (int i = 0; i < NIN; ++i) a.in[i] = (const float*)d_in[i];
    a.out = (float*)d_out; a.ws = (unsigned char*)d_ws;
#if MK_ONE_LAUNCH
    a.ph_lo = 0; a.ph_hi = N_PHASES;
    hipLaunchKernelGGL(fwd_kernel, dim3(grid), dim3(NWAVES * 64), LDS_BYTES, stream, a);
#else
    for (int p = 0; p < N_PHASES; ++p) { a.ph_lo = p; a.ph_hi = p + 1;
        hipLaunchKernelGGL(fwd_kernel, dim3(grid), dim3(NWAVES * 64), LDS_BYTES, stream, a); }
#endif
    const hipError_t le = hipPeekAtLastError();
    if (le != hipSuccess) fprintf(stderr, "kernel_launch: launch failed: %s\n", hipGetErrorName(le));
}
```
